# Optimizing an MI355X kernel written in HIP

```python
import math
import jax, jax.numpy as jnp
from jax import lax
import numpy as np

D_MODEL = 2048
BATCH = 4
SEQ = 8192
DEPTH = 4

GRID_W = 64
CTX_LEN = 256
N_MLA_HEADS = 8
Q_RANK = 512
KV_RANK = 256
QK_NOPE = 128
QK_ROPE = 64
V_HEAD = 128
QK_HEAD = QK_NOPE + QK_ROPE
ATTN_SCALE = QK_HEAD ** -0.5
MLA_IN = Q_RANK + KV_RANK + QK_ROPE
MLA_OUT = N_MLA_HEADS * V_HEAD
Q_BLOCK = 128
ROPE_AXIS = QK_ROPE // 2
ROPE_FREQS = ROPE_AXIS // 2
ROPE_THETA = 10000.0
POOL_WIDTH = D_MODEL // 2
POOL_WINDOWS = (2, 4, 8, 16)
POOL_GROUPS = len(POOL_WINDOWS)
POOL_GROUP = POOL_WIDTH // POOL_GROUPS
IN_WIDTH = MLA_IN + POOL_WIDTH
EVEN_MIX_WIDTH = MLA_OUT + POOL_WIDTH
FOURIER_GROUPS = 4
FOURIER_GROUP = D_MODEL // FOURIER_GROUPS
D_FF = 4 * D_MODEL
EPS = 1e-6
N_EVEN = (DEPTH + 1) // 2
N_ODD = DEPTH // 2

kernel_name = 'hybrid_mla_pool_fourier_dit'


def rmsnorm(x, g):
    xf = x.astype(jnp.float32)
    y = xf * lax.rsqrt(jnp.mean(xf * xf, axis=-1, keepdims=True) + EPS)
    return (y * g.astype(jnp.float32)).astype(x.dtype)


def modulate(h, shift, scale):
    return h * (1 + scale) + shift


def axial_rope_tables(n):
    rows = n // GRID_W
    r = jnp.broadcast_to(jnp.arange(rows, dtype=jnp.float32)[:, None], (rows, GRID_W)).reshape(n)
    col = jnp.broadcast_to(jnp.arange(GRID_W, dtype=jnp.float32)[None, :], (rows, GRID_W)).reshape(n)
    inv = ROPE_THETA ** (-2.0 * jnp.arange(ROPE_FREQS, dtype=jnp.float32) / ROPE_AXIS)
    ang = jnp.stack([r[:, None] * inv, col[:, None] * inv], axis=1)
    ang = jnp.broadcast_to(ang[:, :, None, :], (n, 2, 2, ROPE_FREQS)).reshape(n, QK_ROPE)
    return jnp.cos(ang), jnp.sin(ang)


def rotate_half_axial(x):
    xr = x.reshape(x.shape[:-1] + (2, 2, ROPE_FREQS))
    return jnp.concatenate([-xr[..., 1:, :], xr[..., :1, :]], axis=-2).reshape(x.shape)


def apply_rope(x, cos, sin):
    return x * cos + rotate_half_axial(x) * sin


def mla_queries(p, q_norm, w_uq):
    b, n, _ = p.shape
    q = (rmsnorm(p[..., :Q_RANK], q_norm) @ w_uq).reshape(b, n, N_MLA_HEADS, QK_HEAD)
    return q[..., :QK_NOPE], q[..., QK_NOPE:]


def mla_keys(p, kv_norm, w_ukv):
    b, n, _ = p.shape
    kv_lat = p[..., Q_RANK:Q_RANK + KV_RANK]
    k_rope = p[..., Q_RANK + KV_RANK:MLA_IN]
    kv = (rmsnorm(kv_lat, kv_norm) @ w_ukv).reshape(b, n, N_MLA_HEADS, QK_NOPE + V_HEAD)
    return kv[..., :QK_NOPE], k_rope, kv[..., QK_NOPE:]


def attend(qn, qr, kn, kr, v):
    s = jnp.einsum('bqhd,bkhd->bhqk', qn, kn) + jnp.einsum('bqhr,bkr->bhqk', qr, kr)
    p = jax.nn.softmax(s.astype(jnp.float32) * ATTN_SCALE, axis=-1).astype(v.dtype)
    return jnp.einsum('bhqk,bkhd->bqhd', p, v)


def latent_attention(qn, qr, kn, kr, v):
    b, n, h, _ = qn.shape
    nb = n // Q_BLOCK

    def to_blocks(t):
        return jnp.moveaxis(t.reshape((b, nb, Q_BLOCK) + t.shape[2:]), 1, 0)

    out = lax.map(lambda qs: attend(qs[0], qs[1], kn, kr, v), (to_blocks(qn), to_blocks(qr)))
    return jnp.moveaxis(out, 0, 1).reshape(b, n, h * V_HEAD)


def multiscale_pool(u, w_pool, pool_scale):
    b, n, _ = u.shape
    ug = u.reshape(b, n, POOL_GROUPS, POOL_GROUP).astype(jnp.float32)
    cs = jnp.concatenate([jnp.zeros((b, 1, POOL_GROUPS, POOL_GROUP), jnp.float32),
                          jnp.cumsum(ug, axis=1)], axis=1)
    t = jnp.arange(n)
    means = []
    for gi, w in enumerate(POOL_WINDOWS):
        lo = jnp.clip(t - w // 2, 0, n)
        hi = jnp.clip(t + w // 2, 0, n)
        cg = cs[:, :, gi]
        means.append((cg[:, hi] - cg[:, lo]) / (hi - lo).astype(jnp.float32)[None, :, None])
    pooled = (jnp.stack(means, axis=2) - ug).astype(u.dtype)
    y = jnp.einsum('bngc,gcd->bngd', pooled, w_pool)
    return y.reshape(b, n, POOL_WIDTH) * pool_scale


def even_mixer(hx, hc, w_in, q_norm, w_uq, kv_norm, w_ukv, w_pool, pool_scale, w_out, cos, sin, ctx_out):
    px = hx @ w_in
    pc = hc @ w_in
    qn, qr = mla_queries(px, q_norm, w_uq)
    kn, kr, v = mla_keys(px, kv_norm, w_ukv)
    ckn, ckr, cv = mla_keys(pc, kv_norm, w_ukv)
    qr = apply_rope(qr, cos[:, None, :], sin[:, None, :])
    kr = apply_rope(kr, cos, sin)
    kn_all = jnp.concatenate([ckn, kn], axis=1)
    kr_all = jnp.concatenate([ckr, kr], axis=1)
    v_all = jnp.concatenate([cv, v], axis=1)
    attn_x = latent_attention(qn, qr, kn_all, kr_all, v_all)
    pool_x = multiscale_pool(px[..., MLA_IN:], w_pool, pool_scale)
    yx = jnp.concatenate([attn_x, pool_x], axis=-1) @ w_out
    if not ctx_out:
        return yx, None
    b, l, _ = hc.shape
    cqn, cqr = mla_queries(pc, q_norm, w_uq)
    attn_c = attend(cqn, cqr, ckn, ckr, cv).reshape(b, l, MLA_OUT)
    pool_c = multiscale_pool(pc[..., MLA_IN:], w_pool, pool_scale)
    yc = jnp.concatenate([attn_c, pool_c], axis=-1) @ w_out
    return yx, yc


def fourier_mixer(h, w_out):
    b, n, _ = h.shape
    hg = h.astype(jnp.float32).reshape(b, n, FOURIER_GROUPS, FOURIER_GROUP)
    f = jnp.fft.fftn(hg, axes=(1, 3), norm='ortho').real
    return f.reshape(b, n, D_MODEL).astype(h.dtype) @ w_out


def sq_relu_mlp(h, w1, w2):
    return jnp.square(jax.nn.relu(h @ w1)) @ w2


def setup_inputs(seed: int = 0) -> dict:
    key = jax.random.key(seed)
    ks = jax.random.split(key, 20)

    def nrm(k, shape, scale):
        return jax.random.normal(k, shape, jnp.float32) * scale

    return {
        'x': nrm(ks[0], (BATCH, SEQ, D_MODEL), 1.0),
        'c': nrm(ks[1], (BATCH, D_MODEL), 1.0),
        'ctx': nrm(ks[2], (BATCH, CTX_LEN, D_MODEL), 1.0),
        'c_ctx': nrm(ks[3], (D_MODEL,), 1.0),
        'w_mod': nrm(ks[4], (DEPTH, D_MODEL, 6 * D_MODEL), 0.5 * D_MODEL ** -0.5),
        'b_mod': nrm(ks[5], (DEPTH, 6 * D_MODEL), 0.02),
        'norm1': 1.0 + nrm(ks[6], (DEPTH, D_MODEL), 0.05),
        'norm2': 1.0 + nrm(ks[7], (DEPTH, D_MODEL), 0.05),
        'w_in': nrm(ks[8], (N_EVEN, D_MODEL, IN_WIDTH), D_MODEL ** -0.5),
        'q_norm': 1.0 + nrm(ks[9], (N_EVEN, Q_RANK), 0.05),
        'w_uq': nrm(ks[10], (N_EVEN, Q_RANK, N_MLA_HEADS * QK_HEAD), Q_RANK ** -0.5),
        'kv_norm': 1.0 + nrm(ks[11], (N_EVEN, KV_RANK), 0.05),
        'w_ukv': nrm(ks[12], (N_EVEN, KV_RANK, N_MLA_HEADS * (QK_NOPE + V_HEAD)), KV_RANK ** -0.5),
        'w_pool': nrm(ks[13], (N_EVEN, POOL_GROUPS, POOL_GROUP, POOL_GROUP), POOL_GROUP ** -0.5),
        'pool_scale': 1.0 + nrm(ks[14], (N_EVEN, POOL_WIDTH), 0.1),
        'w_out_even': nrm(ks[15], (N_EVEN, EVEN_MIX_WIDTH, D_MODEL), EVEN_MIX_WIDTH ** -0.5),
        'w_out_odd': nrm(ks[16], (N_ODD, D_MODEL, D_MODEL), D_MODEL ** -0.5),
        'w_mlp1': nrm(ks[17], (DEPTH, D_MODEL, D_FF), D_MODEL ** -0.5),
        'w_mlp2': nrm(ks[18], (DEPTH, D_FF, D_MODEL), D_FF ** -0.5),
        'final_norm': 1.0 + nrm(ks[19], (D_MODEL,), 0.05),
    }


def reference(x, c, ctx, c_ctx, w_mod, b_mod, norm1, norm2, w_in, q_norm, w_uq, kv_norm, w_ukv,
              w_pool, pool_scale, w_out_even, w_out_odd, w_mlp1, w_mlp2, final_norm):
    n = x.shape[1]
    cos, sin = axial_rope_tables(n)
    cos = cos.astype(x.dtype)
    sin = sin.astype(x.dtype)
    for l in range(DEPTH):
        last = l == DEPTH - 1
        even = l % 2 == 0
        i = l // 2
        mod_x = (jax.nn.silu(c) @ w_mod[l] + b_mod[l])[:, None, :]
        sh1, sc1, g1, sh2, sc2, g2 = jnp.split(mod_x, 6, axis=-1)
        hx = modulate(rmsnorm(x, norm1[l]), sh1, sc1)
        need_ctx = (not last) or even
        if need_ctx:
            mod_c = jax.nn.silu(c_ctx) @ w_mod[l] + b_mod[l]
            csh1, csc1, cg1, csh2, csc2, cg2 = jnp.split(mod_c, 6, axis=-1)
            hc = modulate(rmsnorm(ctx, norm1[l]), csh1, csc1)
        if even:
            yx, yc = even_mixer(hx, hc, w_in[i], q_norm[i], w_uq[i], kv_norm[i], w_ukv[i],
                                w_pool[i], pool_scale[i], w_out_even[i], cos, sin, not last)
        else:
            yx = fourier_mixer(hx, w_out_odd[i])
            yc = None if last else fourier_mixer(hc, w_out_odd[i])
        x = x + g1 * yx
        x = x + g2 * sq_relu_mlp(modulate(rmsnorm(x, norm2[l]), sh2, sc2), w_mlp1[l], w_mlp2[l])
        if not last:
            ctx = ctx + cg1 * yc
            ctx = ctx + cg2 * sq_relu_mlp(modulate(rmsnorm(ctx, norm2[l]), csh2, csc2),
                                          w_mlp1[l], w_mlp2[l])
    return rmsnorm(x, final_norm)
```

```cpp
#include <hip/hip_runtime.h>
#include <cstdio>
#include <cstdint>

#define LAS __attribute__((address_space(3)))
#define GAS __attribute__((address_space(1)))
typedef unsigned short bf16;
typedef short bf16x8 __attribute__((ext_vector_type(8)));
typedef short s16x4 __attribute__((ext_vector_type(4)));
typedef float f32x2 __attribute__((ext_vector_type(2)));
typedef float f32x4 __attribute__((ext_vector_type(4)));
typedef float f32x16 __attribute__((ext_vector_type(16)));
typedef unsigned u32x2 __attribute__((ext_vector_type(2)));
typedef unsigned u32x4 __attribute__((ext_vector_type(4)));

constexpr int D = 2048, NB = 4, SEQ = 8192, CTXL = 256, DEPTH = 4;
constexpr int TX = NB * SEQ, TC = NB * CTXL, T = TX + TC;
constexpr int NH = 8, QR = 512, KVR = 256, DN = 128, DR = 64, DV = 128, DQK = DN + DR;
constexpr int MLA_IN = QR + KVR + DR, PW = 1024, INW = MLA_IN + PW, INWP = 2048;
constexpr int DFF = 8192, NKEY = SEQ + CTXL, MODW = 6 * D, NMOD = 5;
constexpr float EPS = 1e-6f;
constexpr float ATTN_SCALE = 0.07216878364870322f;

__device__ __forceinline__ unsigned cvt_pk_bf16(float lo, float hi) { unsigned r; asm volatile("v_cvt_pk_bf16_f32 %0, %1, %2" : "=v"(r) : "v"(lo), "v"(hi)); return r; }
__device__ __forceinline__ float bf2f(unsigned short h) { return __builtin_bit_cast(float, (unsigned)h << 16); }
__device__ __forceinline__ float bflo(unsigned w) { return __builtin_bit_cast(float, w << 16); }
__device__ __forceinline__ float bfhi(unsigned w) { return __builtin_bit_cast(float, w & 0xffff0000u); }

typedef unsigned long long u64;
constexpr float SS_FIX = 16777216.0f;
__device__ __forceinline__ float rs_from(u64 v) { return __builtin_amdgcn_rsqf((float)v * (1.0f / (SS_FIX * 2048.0f)) + 1e-6f); }

namespace pg8 {
constexpr int BM = 256, BK = 64, HALF = 128, HTB = HALF * BK * 2, STAGE_BYTES = 8 * HTB, NXCD = 8, WGM = 8;
__host__ __device__ __forceinline__ int lds_byte(int r, int c) { const int st = (r >> 4) * 2 + (c >> 5), rr = r & 15, cc = c & 31, ob = rr * 64 + cc * 2; return st * 1024 + (ob ^ (((ob >> 9) & 1) << 5)); }
__host__ __device__ __forceinline__ void stage_rc(int b, int& R, int& C) { const int st = b / 1024, sb = b % 1024, swz = sb ^ (((sb >> 9) & 1) << 5); R = (st >> 1) * 16 + swz / 64; C = (st & 1) * 32 + (swz % 64) / 2; }
__host__ __device__ __forceinline__ int perm32(int rho) { const int n = rho >> 4, i = rho & 15; return 8 * (i >> 2) + 4 * n + (i & 3); }

struct Unit { int pm, pn; const char* a; const char* b; };

__host__ __device__ __forceinline__ void tile_swz(int L, int nM, int nN, int& pm, int& pn) {
    const int nwg = nM * nN; int wgid = L;
    { const int q = nwg / NXCD, r = nwg % NXCD, xcd = wgid % NXCD, off = wgid / NXCD; wgid = (xcd < r ? xcd * (q + 1) : r * (q + 1) + (xcd - r) * q) + off; }
    const int nig = WGM * nN, gid = wgid / nig, fm = gid * WGM, gsz = (nM - fm) < WGM ? (nM - fm) : WGM;
    pm = fm + ((wgid % nig) % gsz); pn = (wgid % nig) / gsz;
}
template <class Map> struct Strided {
    Map m; int G, c;
    __device__ __forceinline__ bool next(int i, Unit& u) const { const long L = (long)i * G + c; if (L >= m.total()) return false; m.get((int)L, u); return true; }
};
struct MapStd {
    const char* A; const char* B; long a_tile, b_tile; int nM, nN;
    __device__ __forceinline__ int total() const { return nM * nN; }
    __device__ __forceinline__ void get(int L, Unit& u) const { int pm, pn; tile_swz(L, nM, nN, pm, pn); u.pm = pm; u.pn = pn; u.a = A + (long)pm * a_tile; u.b = B + (long)pn * b_tile; }
};
struct Geo { int K; unsigned lda, ldb; unsigned ksa = BK * 2, ksb = BK * 2; unsigned a32 = 0; };

template <int ACT  > struct EpiStore {
    static constexpr bool PERM = true;
    bf16* O; long ld;
    __device__ __forceinline__ void operator()(const f32x4 (&acc)[2][2][4][2], const Unit& u, int wr, int wc, int fr, int fq) const {
        const long row0 = (long)u.pm * BM + wr * 64 + fr; const int col0 = u.pn * BM + wc * 32 + 8 * fq;
#pragma unroll
        for (int ai = 0; ai < 2; ++ai)
#pragma unroll
            for (int m = 0; m < 4; ++m) { bf16* rowp = O + (row0 + ai * HALF + m * 16) * ld + col0;
#pragma unroll
                for (int bj = 0; bj < 2; ++bj) { f32x4 v0 = acc[ai][bj][m][0], v1 = acc[ai][bj][m][1];
                    if (ACT == 1) {
#pragma unroll
                        for (int e = 0; e < 4; ++e) { const float a = fmaxf(v0[e], 0.f), b = fmaxf(v1[e], 0.f); v0[e] = a * a; v1[e] = b * b; } }
                    u32x4 w; w.x = cvt_pk_bf16(v0[0], v0[1]); w.y = cvt_pk_bf16(v0[2], v0[3]); w.z = cvt_pk_bf16(v1[0], v1[1]); w.w = cvt_pk_bf16(v1[2], v1[3]);
                    *(u32x4*)(rowp + bj * HALF) = w; } }
    }
};
struct EpiNormStore {
    static constexpr bool PERM = true;
    bf16* O; long ld; const u64* st; const float* bias; int ldb;
    __device__ __forceinline__ void operator()(const f32x4 (&acc)[2][2][4][2], const Unit& u, int wr, int wc, int fr, int fq) const {
        const long row0 = (long)u.pm * BM + wr * 64 + fr; const int col0 = u.pn * BM + wc * 32 + 8 * fq; const int j = u.pm < 128 ? (u.pm >> 5) : 4;
        f32x4 bv[2][2];
#pragma unroll
        for (int bj = 0; bj < 2; ++bj)
#pragma unroll
            for (int n = 0; n < 2; ++n) bv[bj][n] = *(const f32x4*)(bias + (long)j * ldb + col0 + bj * HALF + 4 * n);
        float rsa[8]; u64 sva[8];
#pragma unroll
        for (int rg = 0; rg < 8; ++rg) sva[rg] = st[row0 + (rg >> 2) * HALF + (rg & 3) * 16];
        __builtin_amdgcn_sched_barrier(0);
#pragma unroll
        for (int rg = 0; rg < 8; ++rg) rsa[rg] = rs_from(sva[rg]);
#pragma unroll
        for (int ai = 0; ai < 2; ++ai)
#pragma unroll
            for (int m = 0; m < 4; ++m) { const long row = row0 + ai * HALF + m * 16; const float rs = rsa[ai * 4 + m]; bf16* rowp = O + row * ld + col0;
#pragma unroll
                for (int bj = 0; bj < 2; ++bj) { const f32x4 v0 = acc[ai][bj][m][0] * rs + bv[bj][0], v1 = acc[ai][bj][m][1] * rs + bv[bj][1];
                    u32x4 w; w.x = cvt_pk_bf16(v0[0], v0[1]); w.y = cvt_pk_bf16(v0[2], v0[3]); w.z = cvt_pk_bf16(v1[0], v1[1]); w.w = cvt_pk_bf16(v1[2], v1[3]);
                    *(u32x4*)(rowp + bj * HALF) = w; } }
    }
};
struct EpiAct {
    static constexpr bool PERM = true;
    bf16* O; const u64* st; const float* bias;
    __device__ __forceinline__ void operator()(const f32x4 (&acc)[2][2][4][2], const Unit& u, int wr, int wc, int fr, int fq) const {
        bf16* base = O + (((long)u.pm * (DFF / 32) + u.pn * 8 + wc) * 256 + wr * 64 + fr) * 32 + 8 * fq;
        const int j = u.pm < 128 ? (u.pm >> 5) : 4; const int col0 = u.pn * BM + wc * 32 + 8 * fq; const long row0 = (long)u.pm * BM + wr * 64 + fr;
        f32x4 bv[2][2];
#pragma unroll
        for (int bj = 0; bj < 2; ++bj)
#pragma unroll
            for (int n = 0; n < 2; ++n) bv[bj][n] = *(const f32x4*)(bias + (long)j * DFF + col0 + bj * HALF + 4 * n);
        float rsa[8]; u64 sva[8];
#pragma unroll
        for (int rg = 0; rg < 8; ++rg) sva[rg] = st[row0 + (rg >> 2) * HALF + (rg & 3) * 16];
        __builtin_amdgcn_sched_barrier(0);
#pragma unroll
        for (int rg = 0; rg < 8; ++rg) rsa[rg] = rs_from(sva[rg]);
#pragma unroll
        for (int ai = 0; ai < 2; ++ai)
#pragma unroll
            for (int m = 0; m < 4; ++m) { const float rs = rsa[ai * 4 + m];
#pragma unroll
                for (int bj = 0; bj < 2; ++bj) { f32x4 v0 = acc[ai][bj][m][0] * rs + bv[bj][0], v1 = acc[ai][bj][m][1] * rs + bv[bj][1];
#pragma unroll
                    for (int e = 0; e < 4; ++e) { const float a = fmaxf(v0[e], 0.f), b = fmaxf(v1[e], 0.f); v0[e] = a * a; v1[e] = b * b; }
                    u32x4 w; w.x = cvt_pk_bf16(v0[0], v0[1]); w.y = cvt_pk_bf16(v0[2], v0[3]); w.z = cvt_pk_bf16(v1[0], v1[1]); w.w = cvt_pk_bf16(v1[2], v1[3]);
                    *(u32x4*)(base + ((long)bj * 4 * 256 + ai * HALF + m * 16) * 32) = w; } }
    }
};
struct EpiKV {
    static constexpr bool PERM = true;
    bf16* KB; bf16* VB;
    __device__ __forceinline__ void operator()(const f32x4 (&acc)[2][2][4][2], const Unit& u, int wr, int wc, int fr, int fq) const {
        const int b = u.pm < 128 ? (u.pm >> 5) : (u.pm - 128); const int key0 = u.pm < 128 ? 256 + (u.pm & 31) * 256 : 0;
        const long kr0 = (long)b * NKEY + key0 + wr * 64 + fr; const int c0 = wc * 32 + 8 * fq;
#pragma unroll
        for (int ai = 0; ai < 2; ++ai)
#pragma unroll
            for (int m = 0; m < 4; ++m) { const long kr = kr0 + ai * HALF + m * 16;
#pragma unroll
                for (int bj = 0; bj < 2; ++bj) { const f32x4 v0 = acc[ai][bj][m][0], v1 = acc[ai][bj][m][1];
                    u32x4 w; w.x = cvt_pk_bf16(v0[0], v0[1]); w.y = cvt_pk_bf16(v0[2], v0[3]); w.z = cvt_pk_bf16(v1[0], v1[1]); w.w = cvt_pk_bf16(v1[2], v1[3]);
                    bf16* p = bj == 0 ? KB + kr * (NH * DQK) + u.pn * DQK + c0 : VB + kr * (NH * DV) + u.pn * DV + c0;
                    *(u32x4*)p = w; } }
    }
};
struct EpiPool {
    static constexpr bool PERM = true;
    bf16* CAT; const float* pscale;
    __device__ __forceinline__ void operator()(const f32x4 (&acc)[2][2][4][2], const Unit& u, int wr, int wc, int fr, int fq) const {
        const long row0 = (long)u.pm * BM + wr * 64 + fr; const int col0 = u.pn * BM + wc * 32 + 8 * fq;
        f32x4 sv[2][2];
#pragma unroll
        for (int bj = 0; bj < 2; ++bj)
#pragma unroll
            for (int n = 0; n < 2; ++n) sv[bj][n] = *(const f32x4*)(pscale + col0 + bj * HALF + 4 * n);
#pragma unroll
        for (int ai = 0; ai < 2; ++ai)
#pragma unroll
            for (int m = 0; m < 4; ++m) { bf16* rowp = CAT + (row0 + ai * HALF + m * 16) * D + PW + col0;
#pragma unroll
                for (int bj = 0; bj < 2; ++bj) { const f32x4 v0 = acc[ai][bj][m][0] * sv[bj][0], v1 = acc[ai][bj][m][1] * sv[bj][1];
                    u32x4 w; w.x = cvt_pk_bf16(v0[0], v0[1]); w.y = cvt_pk_bf16(v0[2], v0[3]); w.z = cvt_pk_bf16(v1[0], v1[1]); w.w = cvt_pk_bf16(v1[2], v1[3]);
                    *(u32x4*)(rowp + bj * HALF) = w; } }
    }
};
struct EpiQ {
    static constexpr bool PERM = false;
    bf16* Q; const f32x2* rope;
    __device__ __forceinline__ void operator()(const f32x4 (&acc)[2][2][4][2], const Unit& u, int wr, int wc, int fr, int fq) const {
        const bool isx = u.pm < 128; const f32x2* __restrict__ rope = this->rope; bf16* __restrict__ Q = this->Q;
#pragma unroll
        for (int ai = 0; ai < 2; ++ai)
#pragma unroll
            for (int m = 0; m < 4; ++m) { const int row = u.pm * BM + ai * HALF + wr * 64 + m * 16 + fr; const int t = row & (SEQ - 1); const int pos0 = t >> 6, pos1 = t & 63;
#pragma unroll
                for (int bj = 0; bj < 2; ++bj) { const int cb = u.pn * BM + bj * HALF + wc * 32; const int dd = cb % DQK;
                    f32x4 v0 = acc[ai][bj][m][0], v1 = acc[ai][bj][m][1];
                    if (dd >= DN && isx) { const int pos = ((dd - DN) >> 5) ? pos1 : pos0; const f32x4* rp = (const f32x4*)(rope + pos * 16 + 4 * fq);
                        const f32x4 r0 = rp[0], r1 = rp[1];
                        const float c[4] = {r0[0], r0[2], r1[0], r1[2]}, s[4] = {r0[1], r0[3], r1[1], r1[3]};
#pragma unroll
                        for (int e = 0; e < 4; ++e) { const float x0 = v0[e], x1 = v1[e]; v0[e] = x0 * c[e] - x1 * s[e]; v1[e] = x1 * c[e] + x0 * s[e]; } }
                    bf16* p = Q + (long)row * (NH * DQK) + cb + 4 * fq;
                    u32x2 w0, w1; w0.x = cvt_pk_bf16(v0[0], v0[1]); w0.y = cvt_pk_bf16(v0[2], v0[3]); w1.x = cvt_pk_bf16(v1[0], v1[1]); w1.y = cvt_pk_bf16(v1[2], v1[3]);
                    *(u32x2*)p = w0; *(u32x2*)(p + 16) = w1; } }
    }
};
struct EpiResid {
    static constexpr bool PERM = false;
    const float* Xin; float* Xout; const float* gate;
    __device__ __forceinline__ void operator()(const f32x4 (&acc)[2][2][4][2], const Unit& u, int wr, int wc, int fr, int fq) const {
        const int j = u.pm < 128 ? (u.pm >> 5) : 4; const float* gp = gate + (long)j * MODW; const int col0 = u.pn * BM + wc * 32 + 4 * fq;
        f32x4 gv[2][2];
#pragma unroll
        for (int bj = 0; bj < 2; ++bj)
#pragma unroll
            for (int n = 0; n < 2; ++n) gv[bj][n] = *(const f32x4*)(gp + col0 + bj * HALF + n * 16);
#pragma unroll
        for (int ai = 0; ai < 2; ++ai)
#pragma unroll
            for (int m = 0; m < 4; ++m) { const long off = ((long)u.pm * BM + ai * HALF + wr * 64 + m * 16 + fr) * D + col0;
#pragma unroll
                for (int bj = 0; bj < 2; ++bj)
#pragma unroll
                    for (int n = 0; n < 2; ++n) { const f32x4 xs = *(const f32x4*)(Xin + off + bj * HALF + n * 16); *(f32x4*)(Xout + off + bj * HALF + n * 16) = xs + gv[bj][n] * acc[ai][bj][m][n]; }
                if (m & 1) asm volatile("" ::: "memory"); }
    }
};

struct EpiResidN {
    static constexpr bool PERM = true;
    const float* Xin; float* Xout; const float* gate; const float* gm; bf16* XG; u64* st;
    int in_tiled, out_tiled;
    __device__ __forceinline__ void operator()(const f32x4 (&acc)[2][2][4][2], const Unit& u, int wr, int wc, int fr, int fq) const {
        const int j = u.pm < 128 ? (u.pm >> 5) : 4; const float* gp = gate + (long)j * MODW; const float* mp = gm + (long)j * D; const int col0 = u.pn * BM + wc * 32 + 8 * fq;
        f32x4 gv[2][2], mv[2][2];
#pragma unroll
        for (int bj = 0; bj < 2; ++bj)
#pragma unroll
            for (int n = 0; n < 2; ++n) { gv[bj][n] = *(const f32x4*)(gp + col0 + bj * HALF + n * 4); mv[bj][n] = st ? *(const f32x4*)(mp + col0 + bj * HALF + n * 4) : (f32x4){0.f, 0.f, 0.f, 0.f}; }
        const long rowb = (long)u.pm * BM + wr * 64 + fr;
        const long tb16 = (((long)(u.pm * 8 + u.pn) * 8 + (wr * 4 + wc)) * 1024 + (fq * 16 + fr)) * 8;
        const bf16* XTi = (const bf16*)Xin; bf16* XTo = (bf16*)Xout;
        f32x4 xr[3][2][2];
#define ER_LOAD(rg, slot) do { if (in_tiled) { _Pragma("unroll") for (int bj = 0; bj < 2; ++bj) { const u32x4 w_ = *(const u32x4*)(XTi + tb16 + (rg) * 1024 + bj * 512); \
                xr[slot][bj][0] = (f32x4){bflo(w_.x), bfhi(w_.x), bflo(w_.y), bfhi(w_.y)}; xr[slot][bj][1] = (f32x4){bflo(w_.z), bfhi(w_.z), bflo(w_.w), bfhi(w_.w)}; } } \
            else { const long off_ = (rowb + ((rg) >> 2) * HALF + ((rg) & 3) * 16) * D + col0; \
                _Pragma("unroll") for (int bj = 0; bj < 2; ++bj) _Pragma("unroll") for (int n = 0; n < 2; ++n) xr[slot][bj][n] = *(const f32x4*)(Xin + off_ + bj * HALF + n * 4); } } while (0)
        ER_LOAD(0, 0); ER_LOAD(1, 1);
#pragma unroll
        for (int rg = 0; rg < 8; ++rg) { const int ai = rg >> 2, m = rg & 3, sl = rg % 3;
            if (rg + 2 < 8) ER_LOAD(rg + 2, (rg + 2) % 3);
            const long row = rowb + ai * HALF + m * 16; const long off = row * D + col0; float ss = 0.f;
#pragma unroll
            for (int bj = 0; bj < 2; ++bj) { f32x4 xs[2];
#pragma unroll
                for (int n = 0; n < 2; ++n) { xs[n] = xr[sl][bj][n] + gv[bj][n] * acc[ai][bj][m][n]; ss += (xs[n][0] * xs[n][0] + xs[n][1] * xs[n][1]) + (xs[n][2] * xs[n][2] + xs[n][3] * xs[n][3]); }
                if (out_tiled) { u32x4 w; w.x = cvt_pk_bf16(xs[0][0], xs[0][1]); w.y = cvt_pk_bf16(xs[0][2], xs[0][3]); w.z = cvt_pk_bf16(xs[1][0], xs[1][1]); w.w = cvt_pk_bf16(xs[1][2], xs[1][3]);
                    *(u32x4*)(XTo + tb16 + rg * 1024 + bj * 512) = w; }
                else { *(f32x4*)(Xout + off + bj * HALF) = xs[0]; *(f32x4*)(Xout + off + bj * HALF + 4) = xs[1]; }
                if (st) { const f32x4 h0 = xs[0] * mv[bj][0], h1 = xs[1] * mv[bj][1]; u32x4 w; w.x = cvt_pk_bf16(h0[0], h0[1]); w.y = cvt_pk_bf16(h0[2], h0[3]); w.z = cvt_pk_bf16(h1[0], h1[1]); w.w = cvt_pk_bf16(h1[2], h1[3]);
                    *(u32x4*)(XG + off + bj * HALF) = w; } }
            if (st) { ss += __shfl_xor(ss, 16); ss += __shfl_xor(ss, 32);
                if (fq == 0) __hip_atomic_fetch_add(st + row, (u64)(ss * SS_FIX), __ATOMIC_RELAXED, __HIP_MEMORY_SCOPE_AGENT); }
        }
#undef ER_LOAD
    }
};
struct EpiPartF32 {
    static constexpr bool PERM = false;
    float* O;
    __device__ __forceinline__ void operator()(const f32x4 (&acc)[2][2][4][2], const Unit& u, int wr, int wc, int fr, int fq) const {
        const int col0 = u.pn * BM + wc * 32 + 4 * fq;
#pragma unroll
        for (int ai = 0; ai < 2; ++ai)
#pragma unroll
            for (int m = 0; m < 4; ++m) { float* rowp = O + ((long)u.pm * BM + ai * HALF + wr * 64 + m * 16 + fr) * D + col0;
#pragma unroll
                for (int bj = 0; bj < 2; ++bj)
#pragma unroll
                    for (int n = 0; n < 2; ++n) *(f32x4*)(rowp + bj * HALF + n * 16) = acc[ai][bj][m][n]; }
    }
};
struct MapSplitK {
    const char* A; const char* B; long a_tile, b_tile; long ka, kb;
    __device__ __forceinline__ int total() const { return 256; }
    __device__ __forceinline__ void get(int L, Unit& u) const { const int sp = L >> 5, pmc = (L >> 3) & 3, pn = L & 7;
        u.a = A + (long)(128 + pmc) * a_tile + sp * ka; u.b = B + (long)pn * b_tile + sp * kb; u.pm = sp * 4 + pmc; u.pn = pn; }
};

struct EpiYt {
    static constexpr bool PERM = true;
    bf16* Yt; const u64* st; const float* bias;
    __device__ __forceinline__ void operator()(const f32x4 (&acc)[2][2][4][2], const Unit& u, int wr, int wc, int fr, int fq) const {
        const int pmr = u.pm & 3, g = (u.pm >> 2) & 3, b = u.pm >> 4, ri = pmr >> 1; const int mr0 = (pmr & 1) * 256 + wr * 64 + fr; const int m0 = g * 512 + mr0;
        const float* bp = bias + (b * 4 + g) * 1024 + ri * 512 + mr0;
        float rsv[2][8]; u64 svv[2][8];
#pragma unroll
        for (int bj = 0; bj < 2; ++bj)
#pragma unroll
            for (int e = 0; e < 8; ++e) svv[bj][e] = st[(long)b * SEQ + (8 * fq + e) * 256 + u.pn * 8 + bj * 4 + wc];
        __builtin_amdgcn_sched_barrier(0);
#pragma unroll
        for (int bj = 0; bj < 2; ++bj)
#pragma unroll
            for (int e = 0; e < 8; ++e) rsv[bj][e] = rs_from(svv[bj][e]);
        float bsa[8];
#pragma unroll
        for (int rg = 0; rg < 8; ++rg) bsa[rg] = bp[(rg >> 2) * HALF + (rg & 3) * 16];
#pragma unroll
        for (int ai = 0; ai < 2; ++ai)
#pragma unroll
            for (int m = 0; m < 4; ++m) { const long mp = (long)b * D + m0 + ai * HALF + m * 16; const float bs = bsa[ai * 4 + m];
#pragma unroll
                for (int bj = 0; bj < 2; ++bj) { const f32x4 a0 = acc[ai][bj][m][0], a1 = acc[ai][bj][m][1]; const int j2 = u.pn * 8 + bj * 4 + wc;
                    u32x4 w; w.x = cvt_pk_bf16(a0[0] * rsv[bj][0] + bs, a0[1] * rsv[bj][1] + bs); w.y = cvt_pk_bf16(a0[2] * rsv[bj][2] + bs, a0[3] * rsv[bj][3] + bs);
                    w.z = cvt_pk_bf16(a1[0] * rsv[bj][4] + bs, a1[1] * rsv[bj][5] + bs); w.w = cvt_pk_bf16(a1[2] * rsv[bj][6] + bs, a1[3] * rsv[bj][7] + bs);
                    *(u32x4*)(Yt + ((mp * 256 + j2) * 64 + ri * 32 + 8 * fq)) = w; } }
    }
};
struct EpiYtc {
    static constexpr bool PERM = true;
    bf16* O; const u64* st; const float* bias;
    __device__ __forceinline__ void operator()(const f32x4 (&acc)[2][2][4][2], const Unit& u, int wr, int wc, int fr, int fq) const {
        const int b = u.pm >> 3, g = (u.pm >> 1) & 3, ri = u.pn; const int mr0 = (u.pm & 1) * 256 + wr * 64 + fr;
        const float* bp = bias + (16 + g) * 1024 + ri * 512 + mr0;
        float rsv[2][8];
#pragma unroll
        for (int bj = 0; bj < 2; ++bj)
#pragma unroll
            for (int e = 0; e < 8; ++e) rsv[bj][e] = rs_from(st[(long)TX + b * CTXL + bj * HALF + wc * 32 + 8 * fq + e]);
        float bsa[8];
#pragma unroll
        for (int rg = 0; rg < 8; ++rg) bsa[rg] = bp[(rg >> 2) * HALF + (rg & 3) * 16];
#pragma unroll
        for (int ai = 0; ai < 2; ++ai)
#pragma unroll
            for (int m = 0; m < 4; ++m) { bf16* rowp = O + ((long)u.pm * BM + ai * HALF + wr * 64 + m * 16 + fr) * (2 * CTXL) + ri * CTXL + wc * 32 + 8 * fq; const float bs = bsa[ai * 4 + m];
#pragma unroll
                for (int bj = 0; bj < 2; ++bj) { const f32x4 a0 = acc[ai][bj][m][0], a1 = acc[ai][bj][m][1];
                    u32x4 w; w.x = cvt_pk_bf16(a0[0] * rsv[bj][0] + bs, a0[1] * rsv[bj][1] + bs); w.y = cvt_pk_bf16(a0[2] * rsv[bj][2] + bs, a0[3] * rsv[bj][3] + bs);
                    w.z = cvt_pk_bf16(a1[0] * rsv[bj][4] + bs, a1[1] * rsv[bj][5] + bs); w.w = cvt_pk_bf16(a1[2] * rsv[bj][6] + bs, a1[3] * rsv[bj][7] + bs);
                    *(u32x4*)(rowp + bj * HALF) = w; } }
    }
};
struct EpiF2 {
    static constexpr bool PERM = true;
    bf16* G;
    __device__ __forceinline__ void operator()(const f32x4 (&acc)[2][2][4][2], const Unit& u, int wr, int wc, int fr, int fq) const {
        asm volatile("" : "+v"(fr));
#pragma unroll
        for (int ai = 0; ai < 2; ++ai)
#pragma unroll
            for (int m = 0; m < 4; ++m) { const int R = u.pm * BM + ai * HALF + wr * 64 + m * 16 + fr; const int j2q = R & 63, mp = (R >> 6) & (D - 1), b = R >> 17;
#pragma unroll
                for (int bj = 0; bj < 2; ++bj) { const int k1 = bj * 16 + wc * 4 + fq; float c[4], sn[4];
#pragma unroll
                    for (int e = 0; e < 4; ++e) { const float rev = (float)((4 * j2q + e) * k1) * (1.0f / 8192.0f); c[e] = __builtin_amdgcn_cosf(rev); sn[e] = __builtin_amdgcn_sinf(rev); }
                    const f32x4 gr = acc[ai][bj][m][0], gi = acc[ai][bj][m][1]; float orr[4], oi[4];
#pragma unroll
                    for (int e = 0; e < 4; ++e) { orr[e] = c[e] * gr[e] + sn[e] * gi[e]; oi[e] = c[e] * gi[e] - sn[e] * gr[e]; }
                    bf16* p = G + ((((long)b * 32 + k1) * D + mp) * 512 + 4 * j2q);
                    u32x2 w0, w1; w0.x = cvt_pk_bf16(orr[0], orr[1]); w0.y = cvt_pk_bf16(orr[2], orr[3]); w1.x = cvt_pk_bf16(oi[0], oi[1]); w1.y = cvt_pk_bf16(oi[2], oi[3]);
                    *(u32x2*)p = w0; *(u32x2*)(p + 256) = w1; __builtin_amdgcn_sched_barrier(0); } }
    }
};
struct EpiF3 {
    static constexpr bool PERM = true;
    bf16* O;
    __device__ __forceinline__ void operator()(const f32x4 (&acc)[2][2][4][2], const Unit& u, int wr, int wc, int fr, int fq) const {
        const long row0 = (long)(u.pm >> 5) * SEQ + (u.pm & 31); const int col0 = u.pn * BM + wc * 32 + 8 * fq;
#pragma unroll
        for (int ai = 0; ai < 2; ++ai)
#pragma unroll
            for (int m = 0; m < 4; ++m) { bf16* rowp = O + (row0 + 32 * (ai * HALF + wr * 64 + m * 16 + fr)) * D + col0;
#pragma unroll
                for (int bj = 0; bj < 2; ++bj) { const f32x4 v0 = acc[ai][bj][m][0], v1 = acc[ai][bj][m][1];
                    u32x4 w; w.x = cvt_pk_bf16(v0[0], v0[1]); w.y = cvt_pk_bf16(v0[2], v0[3]); w.z = cvt_pk_bf16(v1[0], v1[1]); w.w = cvt_pk_bf16(v1[2], v1[3]);
                    *(u32x4*)(rowp + bj * HALF) = w; } }
    }
};

template <class Epi, class Sched, bool ALIGN_EPI = true, bool BGATHER = false>
__device__ __forceinline__ void gemm_phase(LAS unsigned char* lds, const Geo g, const Sched& S, const Epi& E) {
    int tid = threadIdx.x; asm volatile("" : "+v"(tid));
    const int wid = __builtin_amdgcn_readfirstlane(tid >> 6), lane = tid & 63, wr = wid >> 2, wc = wid & 3, fr = lane & 15, fq = lane >> 4;
    int K = g.K; asm volatile("" : "+s"(K));
    const int nt = K / BK;
    unsigned voffA[2], voffB[2];
#pragma unroll
    for (int i = 0; i < 2; ++i) { int R, C; stage_rc(tid * 16 + i * 8192, R, C); const int Rb = Epi::PERM ? ((R & ~31) + perm32(R & 31)) : R;
        voffA[i] = (unsigned)R * g.lda + (g.a32 ? (unsigned)(C & 31) * 2u + (unsigned)(C >> 5) * g.a32 : (unsigned)C * 2u); voffB[i] = (BGATHER ? (unsigned)((Rb & 31) * 256 + (Rb >> 5)) : (unsigned)Rb) * g.ldb + (unsigned)C * 2u; }
    const size_t kstepA = g.ksa, kstepB = g.ksb;
    const size_t hstepA = (size_t)HALF * g.lda, hstepB = (size_t)(BGATHER ? 4 : HALF) * g.ldb;
    const unsigned ldsw = (unsigned)wid * 1024u;
    const int aoff = lds_byte(wr * 64 + fr, fq * 8), boff = lds_byte(wc * 32 + fr, fq * 8);
#define PG8_SA(b, h) (((b) * 2 + (h)) * HTB)
#define PG8_SB(b, h) ((4 + (b) * 2 + (h)) * HTB)
#define PG8_STAGE(bufoff, gbase, voff) do { _Pragma("unroll") for (int _i = 0; _i < 2; ++_i) \
        __builtin_amdgcn_global_load_lds((const unsigned*)((const char*)(gbase) + (voff)[_i]), (LAS unsigned*)(lds + (bufoff) + ldsw + _i * 8192), 16, 0, 0); } while (0)
#define PG8_LDA(dst, b, h) do { _Pragma("unroll") for (int m = 0; m < 4; ++m) _Pragma("unroll") for (int k = 0; k < 2; ++k) dst[m][k] = *(const LAS bf16x8*)(lds + PG8_SA(b, h) + aoff + m * 2048 + k * 1024); } while (0)
#define PG8_LDB(dst, b, h) do { _Pragma("unroll") for (int n = 0; n < 2; ++n) _Pragma("unroll") for (int k = 0; k < 2; ++k) dst[n][k] = *(const LAS bf16x8*)(lds + PG8_SB(b, h) + boff + n * 2048 + k * 1024); } while (0)
#define PG8_MMA(ai, bj, At, Bt) do { __builtin_amdgcn_s_setprio(1); _Pragma("unroll") for (int m = 0; m < 4; ++m) _Pragma("unroll") for (int n = 0; n < 2; ++n) _Pragma("unroll") for (int k = 0; k < 2; ++k) \
        acc[ai][bj][m][n] = __builtin_amdgcn_mfma_f32_16x16x32_bf16(Bt[n][k], At[m][k], acc[ai][bj][m][n], 0, 0, 0); __builtin_amdgcn_s_setprio(0); } while (0)
#define PG8_WAIT_V(n) asm volatile("s_waitcnt vmcnt(" #n ")" ::: "memory")
#define PG8_WAIT_L(n) asm volatile("s_waitcnt lgkmcnt(" #n ")" ::: "memory")
#define PG8_BAR __builtin_amdgcn_s_barrier()
#define PG8_SCHED __builtin_amdgcn_sched_barrier(0)
    Unit cur, nxt; int ui = 0;
    if (!S.next(0, cur)) return;
    f32x4 acc[2][2][4][2];
#pragma unroll
    for (int a = 0; a < 2; ++a)
#pragma unroll
        for (int b = 0; b < 2; ++b)
#pragma unroll
            for (int m = 0; m < 4; ++m)
#pragma unroll
                for (int n = 0; n < 2; ++n) acc[a][b][m][n] = (f32x4){0.f, 0.f, 0.f, 0.f};
    bf16x8 At[4][2], B0[2][2], B1[2][2];
    const char* cA = cur.a; const char* cB = cur.b;
    PG8_STAGE(PG8_SB(0, 0), cB, voffB); PG8_STAGE(PG8_SB(0, 1), cB + hstepB, voffB); PG8_STAGE(PG8_SA(0, 0), cA, voffA); PG8_STAGE(PG8_SA(0, 1), cA + hstepA, voffA);
    if (wr == 1) PG8_BAR;
    PG8_WAIT_V(2); PG8_BAR;
    PG8_STAGE(PG8_SB(1, 0), cB + kstepB, voffB); PG8_STAGE(PG8_SA(1, 0), cA + kstepA, voffA); PG8_STAGE(PG8_SB(1, 1), cB + hstepB + kstepB, voffB);
    PG8_WAIT_V(6); PG8_BAR;
    for (;;) {
        const bool has_next = S.next(ui + 1, nxt);
        const char* nA = has_next ? nxt.a : cA; const char* nB = has_next ? nxt.b : cB;
        for (int t = 0; t < nt; t += 2) {
            const bool last = (t == nt - 2);
            const char* a1 = cA + (size_t)(t + 1) * kstepA;
            const char* a2 = last ? nA : cA + (size_t)(t + 2) * kstepA; const char* b2 = last ? nB : cB + (size_t)(t + 2) * kstepB;
            const char* a3 = a2 + kstepA; const char* b3 = b2 + kstepB;
            PG8_LDB(B0, 0, 0); PG8_LDB(B1, 0, 1); PG8_SCHED; PG8_LDA(At, 0, 0); PG8_STAGE(PG8_SA(1, 1), a1 + hstepA, voffA);
            PG8_WAIT_V(8); PG8_WAIT_L(0); PG8_BAR; PG8_MMA(0, 0, At, B0); PG8_MMA(0, 1, At, B1); PG8_BAR; PG8_SCHED;
            PG8_LDA(At, 0, 1); PG8_STAGE(PG8_SB(0, 0), b2, voffB); PG8_STAGE(PG8_SB(0, 1), b2 + hstepB, voffB); PG8_STAGE(PG8_SA(0, 0), a2, voffA);
            PG8_WAIT_V(8); PG8_WAIT_L(0); PG8_BAR; PG8_MMA(1, 0, At, B0); PG8_MMA(1, 1, At, B1); PG8_BAR; PG8_SCHED;
            PG8_LDB(B0, 1, 0); PG8_LDB(B1, 1, 1); PG8_SCHED; PG8_LDA(At, 1, 0); PG8_STAGE(PG8_SA(0, 1), a2 + hstepA, voffA);
            PG8_WAIT_V(8); PG8_WAIT_L(0); PG8_BAR; PG8_MMA(0, 0, At, B0); PG8_MMA(0, 1, At, B1); PG8_BAR; PG8_SCHED;
            PG8_LDA(At, 1, 1); PG8_STAGE(PG8_SB(1, 0), b3, voffB); PG8_STAGE(PG8_SB(1, 1), b3 + hstepB, voffB); PG8_STAGE(PG8_SA(1, 0), a3, voffA);
            PG8_WAIT_V(8); PG8_WAIT_L(0); PG8_BAR; PG8_MMA(1, 0, At, B0); PG8_MMA(1, 1, At, B1); PG8_BAR; PG8_SCHED;
        }
        if constexpr (ALIGN_EPI) { if (wr == 0) PG8_BAR; }
        E(acc, cur, wr, wc, fr, fq);
        if (!has_next) break;
#pragma unroll
        for (int a = 0; a < 2; ++a)
#pragma unroll
            for (int b = 0; b < 2; ++b)
#pragma unroll
                for (int m = 0; m < 4; ++m)
#pragma unroll
                    for (int n = 0; n < 2; ++n) acc[a][b][m][n] = (f32x4){0.f, 0.f, 0.f, 0.f};
        cur = nxt; cA = nA; cB = nB; ++ui;
        if constexpr (ALIGN_EPI) { if (wr == 1) PG8_BAR; }
    }
    PG8_WAIT_V(0);
    if constexpr (!ALIGN_EPI) { if (wr == 0) PG8_BAR; }
    PG8_BAR;
#undef PG8_SA
#undef PG8_SB
#undef PG8_STAGE
#undef PG8_LDA
#undef PG8_LDB
#undef PG8_MMA
#undef PG8_WAIT_V
#undef PG8_WAIT_L
#undef PG8_BAR
#undef PG8_SCHED
}
}

namespace att {
constexpr int NW = 8, QBLK = 32, KVBLK = 64;
constexpr int LDQ = NH * DQK, LDK = NH * DQK, LDV = NH * DV, LDO = D;
constexpr int SHM_V = KVBLK * DV * 2, SHM_K = KVBLK * DQK * 2, SHM_ATTN = 2 * SHM_V + 2 * SHM_K + NW * 64 * 4;
constexpr float THR = 8.f;
#define SBAR() __builtin_amdgcn_sched_barrier(0)
#define KSWZ(row, colB) ((row) * 384 + ((colB) ^ ((((row) >> 1) & 7) << 4)))
__device__ __forceinline__ int crow(int r, int hi) { return (r & 3) + 8 * (r >> 2) + 4 * hi; }
__device__ __forceinline__ void partialSM(f32x16& p0, f32x16& p1, float& m_reg, float& mn, float& alpha) {
  constexpr float C = ATTN_SCALE * 1.4426950408889634f;
  float pmax = p0[0];
#pragma unroll
  for (int r = 1; r < 16; ++r) pmax = fmaxf(pmax, p0[r]);
#pragma unroll
  for (int r = 0; r < 16; ++r) pmax = fmaxf(pmax, p1[r]);
  { auto rr = __builtin_amdgcn_permlane32_swap(__float_as_uint(pmax), __float_as_uint(pmax), false, false);
    pmax = fmaxf(__uint_as_float(rr[0]), __uint_as_float(rr[1])); }
  if (__builtin_expect(__all(pmax - m_reg <= THR / ATTN_SCALE), 1)) { mn = m_reg; alpha = 1.f; }
  else { mn = fmaxf(m_reg, pmax); alpha = __builtin_amdgcn_exp2f((m_reg - mn) * C); m_reg = mn; }
  const float mnC = -mn * C;
#pragma unroll
  for (int r = 0; r < 16; ++r) p0[r] = fmaf(p0[r], C, mnC);
#pragma unroll
  for (int r = 0; r < 16; ++r) p1[r] = fmaf(p1[r], C, mnC);
#pragma unroll
  for (int r = 0; r < 16; ++r) p0[r] = __builtin_amdgcn_exp2f(p0[r]);
}
__device__ __forceinline__ void finishSM(f32x16& p0, f32x16& p1, float alpha, float& l_reg, bf16x8& pa0, bf16x8& pa1, bf16x8& pa2, bf16x8& pa3) {
#pragma unroll
  for (int r = 0; r < 16; ++r) p1[r] = __builtin_amdgcn_exp2f(p1[r]);
  float ps = 0;
#pragma unroll
  for (int r = 0; r < 16; ++r) ps += p0[r];
#pragma unroll
  for (int r = 0; r < 16; ++r) ps += p1[r];
  { auto rr = __builtin_amdgcn_permlane32_swap(__float_as_uint(ps), __float_as_uint(ps), false, false);
    ps = __uint_as_float(rr[0]) + __uint_as_float(rr[1]); }
  l_reg = l_reg * alpha + ps;
#define PK4(P, BASE, OUT) do { unsigned a0 = cvt_pk_bf16(P[BASE + 0], P[BASE + 1]), a1 = cvt_pk_bf16(P[BASE + 2], P[BASE + 3]);   \
    unsigned b0 = cvt_pk_bf16(P[BASE + 4], P[BASE + 5]), b1 = cvt_pk_bf16(P[BASE + 6], P[BASE + 7]);                              \
    auto r0 = __builtin_amdgcn_permlane32_swap(a0, b0, false, false); auto r1 = __builtin_amdgcn_permlane32_swap(a1, b1, false, false); \
    u32x4 w = {r0[0], r1[0], r0[1], r1[1]}; OUT = __builtin_bit_cast(bf16x8, w); } while (0)
  PK4(p0, 0, pa0); PK4(p0, 8, pa1); PK4(p1, 0, pa2); PK4(p1, 8, pa3);
#undef PK4
}
__device__ __forceinline__ void qkt(f32x16& p0, f32x16& p1, const LAS char* Ks, const bf16x8* qr, int r32, int hi) {
  const int sw = (r32 >> 1) & 7; const LAS char* kb[4];
#pragma unroll
  for (int b = 0; b < 4; ++b) kb[b] = Ks + r32 * 384 + (((2 * b + hi) ^ sw) << 4);
  bf16x8 f0[3], f1[3];
#define KLD(d, slot) do { f0[slot] = *(const LAS bf16x8*)(kb[(d) & 3] + 128 * ((d) >> 2)); f1[slot] = *(const LAS bf16x8*)(kb[(d) & 3] + 128 * ((d) >> 2) + 32 * 384); } while (0)
  KLD(0, 0); KLD(1, 1);
  p0 = f32x16{}; p1 = f32x16{};
#pragma unroll
  for (int d0 = 0; d0 < DQK / 16; ++d0) {
    if (d0 + 2 < DQK / 16) KLD(d0 + 2, (d0 + 2) % 3);
    p0 = __builtin_amdgcn_mfma_f32_32x32x16_bf16(f0[d0 % 3], qr[d0], p0, 0, 0, 0);
    p1 = __builtin_amdgcn_mfma_f32_32x32x16_bf16(f1[d0 % 3], qr[d0], p1, 0, 0, 0);
    SBAR();
  }
#undef KLD
}
__device__ __forceinline__ int v_st(int k, int c) { const int kk = (k & ~0xC) | ((k & 4) << 1) | ((k & 8) >> 1); return ((kk >> 3) * 4 + (c >> 5)) * 512 + ((kk & 7) * 32 + (c & 31)) * 2; }
__device__ __forceinline__ int v_rd_base(int lane) { return ((lane & 3) << 3) | (((lane >> 2) & 3) << 6) | (((lane >> 4) & 1) << 5) | (((lane >> 5) & 1) << 8); }
constexpr int v_rd_off(int d0, int ks, int half) { return d0 * 512 + ks * 4096 + half * 2048; }
template <int OFF> __device__ __forceinline__ s16x4 tr_read(int vb) {
  s16x4 r; asm volatile("ds_read_b64_tr_b16 %0, %1 offset:%2" : "=&v"(r) : "v"(vb), "i"(OFF) : "memory"); return r;
}
template <int D0> __device__ __forceinline__ void pv_one(f32x16& od, int vb, bf16x8 pa0, bf16x8 pa1, bf16x8 pa2, bf16x8 pa3) {
  const s16x4 l0 = tr_read<v_rd_off(D0, 0, 0)>(vb), h0 = tr_read<v_rd_off(D0, 0, 1)>(vb), l1 = tr_read<v_rd_off(D0, 1, 0)>(vb), h1 = tr_read<v_rd_off(D0, 1, 1)>(vb);
  const s16x4 l2 = tr_read<v_rd_off(D0, 2, 0)>(vb), h2 = tr_read<v_rd_off(D0, 2, 1)>(vb), l3 = tr_read<v_rd_off(D0, 3, 0)>(vb), h3 = tr_read<v_rd_off(D0, 3, 1)>(vb);
  asm volatile("s_waitcnt lgkmcnt(0)" ::: "memory"); SBAR();
#define PK(L, H) (bf16x8){L[0], L[1], L[2], L[3], H[0], H[1], H[2], H[3]}
  od = __builtin_amdgcn_mfma_f32_32x32x16_bf16(pa0, PK(l0, h0), od, 0, 0, 0);
  od = __builtin_amdgcn_mfma_f32_32x32x16_bf16(pa1, PK(l1, h1), od, 0, 0, 0);
  od = __builtin_amdgcn_mfma_f32_32x32x16_bf16(pa2, PK(l2, h2), od, 0, 0, 0);
  od = __builtin_amdgcn_mfma_f32_32x32x16_bf16(pa3, PK(l3, h3), od, 0, 0, 0);
#undef PK
}
__device__ __forceinline__ void pv_d0(f32x16* o, int vb, bf16x8 pa0, bf16x8 pa1, bf16x8 pa2, bf16x8 pa3) {
  pv_one<0>(o[0], vb, pa0, pa1, pa2, pa3); pv_one<1>(o[1], vb, pa0, pa1, pa2, pa3); pv_one<2>(o[2], vb, pa0, pa1, pa2, pa3); pv_one<3>(o[3], vb, pa0, pa1, pa2, pa3);
}
__device__ __forceinline__ void attn_unit(const bf16* __restrict__ Qb, const bf16* __restrict__ Kh, const bf16* __restrict__ Vh, bf16* __restrict__ Ob, int seq, LAS char* lds) {
  int tid = threadIdx.x; asm volatile("" : "+v"(tid));
  const int wid = tid >> 6, lane = tid & 63, r32 = lane & 31, hi = lane >> 5;
  LAS char* V_lds = lds; LAS char* K_lds = lds + 2 * SHM_V;
  LAS float* ws = (LAS float*)(lds + 2 * SHM_V + 2 * SHM_K) + wid * 64; LAS float* li_l = ws; LAS float* al_l = ws + 32;
  float m_reg = -1e30f, l_reg = 0; f32x16 o[4] = {}; bf16x8 qr[DQK / 16];
  const bf16* Qw = Qb + (long)(wid * QBLK + r32) * LDQ + hi * 8;
#pragma unroll
  for (int d0 = 0; d0 < DQK / 16; ++d0) qr[d0] = *(const bf16x8*)(Qw + d0 * 16);
  unsigned koff[3], voff[2];
#pragma unroll
  for (int i = 0; i < 3; ++i) { const int q = (wid * 3 + i) * 1024 + 16 * lane, row = q / 384, cp = (q % 384) >> 4, c = (cp & ~7) | ((cp & 7) ^ ((row >> 1) & 7)); koff[i] = (unsigned)(row * (LDK * 2) + c * 16); }
#pragma unroll
  for (int i = 0; i < 2; ++i) { const int q = (wid * 2 + i) * 1024 + 16 * lane, sub = q >> 9, within = (q & 511) >> 1, kk = (sub >> 2) * 8 + (within >> 5), c = (sub & 3) * 32 + (within & 31);
    const int k = (kk & ~0xC) | ((kk & 4) << 1) | ((kk & 8) >> 1); voff[i] = (unsigned)(k * (LDV * 2) + c * 2); }
  const int vb0 = (int)(uintptr_t)V_lds + v_rd_base(lane);
  const int wpk = __builtin_amdgcn_readfirstlane(wid * 3072), wpv = __builtin_amdgcn_readfirstlane(wid * 2048);
#define SDMA(k0, b) do { const char* kg_ = (const char*)Kh + (size_t)(k0) * (LDK * 2); const char* vg_ = (const char*)Vh + (size_t)(k0) * (LDV * 2); \
    _Pragma("unroll") for (int i_ = 0; i_ < 3; ++i_) __builtin_amdgcn_global_load_lds((const unsigned*)(kg_ + koff[i_]), (LAS unsigned*)(K_lds + (b) * SHM_K + wpk + i_ * 1024), 16, 0, 0); \
    _Pragma("unroll") for (int i_ = 0; i_ < 2; ++i_) __builtin_amdgcn_global_load_lds((const unsigned*)(vg_ + voff[i_]), (LAS unsigned*)(V_lds + (b) * SHM_V + wpv + i_ * 1024), 16, 0, 0); } while (0)
#define SWAIT() asm volatile("s_waitcnt vmcnt(0)" ::: "memory")
#define RESC(a) do { if (__any((a) < 1.f)) { if (hi == 0) al_l[r32] = (a); asm volatile("s_waitcnt lgkmcnt(0)" ::: "memory"); \
    _Pragma("unroll") for (int d = 0; d < 4; ++d) _Pragma("unroll") for (int r = 0; r < 16; ++r) o[d][r] *= al_l[crow(r, hi)]; } } while (0)
  f32x16 p0, p1; float mn, al; bf16x8 pa0, pa1, pa2, pa3; const int NT = seq / KVBLK;
  SDMA(0, 0); SWAIT(); __syncthreads();
  for (int j = 0; j < NT; ++j) {
    const int bo = j & 1;
    if (j + 1 < NT) SDMA((j + 1) * KVBLK, bo ^ 1);
    SBAR(); qkt(p0, p1, K_lds + bo * SHM_K, qr, r32, hi);
    partialSM(p0, p1, m_reg, mn, al); RESC(al);
    finishSM(p0, p1, al, l_reg, pa0, pa1, pa2, pa3); SBAR();
    pv_d0(o, vb0 + bo * SHM_V, pa0, pa1, pa2, pa3);
    SWAIT(); __syncthreads();
  }
  if (hi == 0) li_l[r32] = l_reg; asm volatile("s_waitcnt lgkmcnt(0)" ::: "memory");
  float rli[16];
#pragma unroll
  for (int r = 0; r < 16; ++r) rli[r] = __builtin_amdgcn_rcpf(li_l[crow(r, hi)]);
  bf16* Ow = Ob + (long)(wid * QBLK) * LDO;
#pragma unroll
  for (int r = 0; r < 16; ++r) { const int orow = crow(r, hi);
#pragma unroll
    for (int d0 = 0; d0 < 4; ++d0) { const unsigned w = cvt_pk_bf16(o[d0][r] * rli[r], 0.f); Ow[(long)orow * LDO + d0 * 32 + r32] = (bf16)(w & 0xffffu); } }
  __syncthreads();
#undef SDMA
#undef SWAIT
#undef RESC
}
#undef SBAR
}

constexpr size_t MiB = 1u << 20;
constexpr size_t WS_CTL = 0, CTL_ZERO_BYTES = 1 * MiB;
constexpr size_t WS_MOD = 1 * MiB;
constexpr size_t WS_ROPE = 2 * MiB;
constexpr size_t WS_W1BD = 2 * MiB + 262144;
constexpr size_t WS_BC = 3 * MiB, WS_WC = 4 * MiB;
constexpr size_t WS_WIN = 5 * MiB, WS_WUQ = 21 * MiB, WS_WUKV = 24 * MiB, WS_WPOOL = 26 * MiB, WS_WOE = 27 * MiB, WS_WOO = 43 * MiB, WS_W1 = 59 * MiB, WS_W2 = 187 * MiB;
constexpr size_t WS_X = 315 * MiB;
constexpr size_t WS_H = 579 * MiB;
constexpr size_t WS_CAT = 711 * MiB;
constexpr size_t WS_BIG = 843 * MiB;
constexpr size_t WS_ACT = WS_BIG;
constexpr size_t WS_P = WS_BIG, WS_QN = WS_BIG + 132 * MiB, WS_KVN = WS_BIG + 165 * MiB, WS_POOLED = WS_BIG + 182 * MiB, WS_Q = WS_BIG + 248 * MiB, WS_KB = WS_BIG + 347 * MiB, WS_VB = WS_BIG + 446 * MiB;
constexpr size_t WS_PART = WS_BIG;
constexpr size_t WS_YT = WS_BIG, WS_G = WS_BIG + 256 * MiB, WS_YTC = WS_BIG + 512 * MiB;
constexpr size_t WS_PARTK = 1371 * MiB;
constexpr size_t WS_STATS = 1435 * MiB;
constexpr size_t STATS_ZERO_BYTES = 3 * MiB;
constexpr size_t WS_GM = 1438 * MiB;
constexpr size_t WS_BIASP = 1439 * MiB;
constexpr size_t WS_BIASA = 1440 * MiB;
constexpr size_t WS_BIASF = 1441 * MiB;
constexpr size_t WS_END = 1442 * MiB;
static_assert((size_t)DEPTH * 2 * T * 8 <= STATS_ZERO_BYTES && (size_t)DEPTH * 5 * DFF * 4 <= MiB, "stats / bias tables");
static_assert(WS_VB + (size_t)NB * NKEY * NH * DV * 2 <= WS_END && WS_YTC + (size_t)NB * D * 2 * CTXL * 2 <= WS_END && WS_ACT + (size_t)T * DFF * 2 <= WS_END, "ws map");
constexpr int CW_BAR = 4096;

constexpr int RING_BYTES = 131072, LDSCTL_OFF = RING_BYTES, MISC_OFF = LDSCTL_OFF + 320, LDS_BYTES = 147456;
constexpr int SCR_PER_WAVE = 8704, SILU_OFF = 73728;
static_assert(att::SHM_ATTN <= RING_BYTES && pg8::STAGE_BYTES <= RING_BYTES && 8 * SCR_PER_WAVE <= SILU_OFF && SILU_OFF + NMOD * D * 4 <= RING_BYTES, "LDS map");

#define RLX_AGENT __ATOMIC_RELAXED, __HIP_MEMORY_SCOPE_AGENT
#define LDS_WAIT() asm volatile("s_waitcnt lgkmcnt(0)" ::: "memory")

#define XB_TMO      128
#define XB_XCNT(j)  (256  + 64 * (j))
#define XB_XSUB(j)  (1280 + 64 * (j))
#define XB_XGEN(j)  (2304 + 64 * (j))
#define XB_TOP      3328
#define XB_TOPGEN   3392
#define XCD_BAR_WORDS 3456
#define XB_SPIN_CAP (1u << 22)
__device__ __forceinline__ unsigned xb_ld(unsigned* p)              { return __hip_atomic_load(p, __ATOMIC_RELAXED, __HIP_MEMORY_SCOPE_AGENT); }
__device__ __forceinline__ unsigned xb_add(unsigned* p, unsigned v) { return __hip_atomic_fetch_add(p, v, __ATOMIC_RELAXED, __HIP_MEMORY_SCOPE_AGENT); }
__device__ __forceinline__ unsigned xb_xcc_id() { return (unsigned)__builtin_amdgcn_s_getreg((3 << 11) | 20) & 0xFu; }
#define XB_SPIN(cond, bar) do { unsigned _sp = 0; while (cond) { __builtin_amdgcn_s_sleep(1); \
    if ((++_sp & 255u) == 0u) { if (xb_ld(&(bar)[XB_TMO])) break; if (_sp > XB_SPIN_CAP) { atomicAdd(&(bar)[XB_TMO], 1u); break; } } } } while (0)
struct XcdBarrier { unsigned* bar; unsigned x; volatile LAS unsigned* st; };
__device__ __forceinline__ XcdBarrier xcd_barrier_post(unsigned* bar, volatile LAS unsigned* st) {
    XcdBarrier b; b.bar = bar; b.x = xb_xcc_id(); b.st = st;
    if (threadIdx.x == 0) (void)xb_add(&bar[XB_XCNT(b.x)], 1u);
    return b;
}
__device__ __forceinline__ void xcd_barrier_complete(unsigned* bar, unsigned x, unsigned& nloc, unsigned& nx) {
    const unsigned G = gridDim.x * gridDim.y * gridDim.z;
    unsigned sum, cnt, mine, sp = 0u;
    for (;;) {
        sum = 0u; cnt = 0u; mine = 0u;
#pragma unroll
        for (unsigned j = 0; j < 16; ++j) { const unsigned c = xb_ld(&bar[XB_XCNT(j)]); sum += c; cnt += (c > 0u) ? 1u : 0u; mine = (j == x) ? c : mine; }
        if (sum == G) break;
        __builtin_amdgcn_s_sleep(1);
        if ((++sp & 255u) == 0u) { if (xb_ld(&bar[XB_TMO])) break; if (sp > XB_SPIN_CAP) { atomicAdd(&bar[XB_TMO], 1u); break; } }
    }
    nloc = mine > 0u ? mine : 1u; nx = cnt > 0u ? cnt : 1u;
}
__device__ __forceinline__ void xcd_barrier(const XcdBarrier& b) {
    asm volatile("s_waitcnt vmcnt(0)" ::: "memory");
    __syncthreads();
    int t0_ = threadIdx.x; asm volatile("" : "+v"(t0_));
    if (t0_ == 0) {
        unsigned* bar = b.bar;
        __builtin_amdgcn_s_waitcnt(0);
        unsigned nloc = b.st[0], nx = b.st[1];
        if (nloc == 0u) { xcd_barrier_complete(bar, b.x, nloc, nx); b.st[0] = nloc; b.st[1] = nx; }
        const unsigned old = xb_add(&bar[XB_XSUB(b.x)], 1u);
        const unsigned gen = old / nloc;
        if (old + 1u == (gen + 1u) * nloc) {
            __builtin_amdgcn_fence(__ATOMIC_RELEASE, "agent");
            asm volatile("s_waitcnt vmcnt(0)" ::: "memory");
            const unsigned og = xb_add(&bar[XB_TOP], 1u);
            const unsigned tg = og / nx;
            if (og + 1u == (tg + 1u) * nx) xb_add(&bar[XB_TOPGEN], 1u);
            else XB_SPIN(xb_ld(&bar[XB_TOPGEN]) == tg, bar);
            __builtin_amdgcn_fence(__ATOMIC_ACQUIRE, "agent");
            xb_add(&bar[XB_XGEN(b.x)], 1u);
            asm volatile("s_waitcnt vmcnt(0)" ::: "memory");
        } else {
            XB_SPIN(xb_ld(&bar[XB_XGEN(b.x)]) == gen, bar);
            __builtin_amdgcn_fence(__ATOMIC_ACQUIRE, "agent");
            asm volatile("s_waitcnt vmcnt(0)" ::: "memory");
        }
    }
    __syncthreads();
}

__device__ __forceinline__ float wave_sum(float v) {
#pragma unroll
    for (int o = 1; o < 64; o <<= 1) v += __shfl_xor(v, o);
    return v;
}
struct Ctx { LAS unsigned char* lds; int vcu, G, NGW; };
struct LaneV { int tid, lane, wave, gw; };
__device__ __forceinline__ LaneV lane_view(const Ctx& F) { LaneV v; int t = threadIdx.x; asm volatile("" : "+v"(t)); v.tid = t; v.lane = t & 63; v.wave = __builtin_amdgcn_readfirstlane(t >> 6); v.gw = F.vcu * 8 + v.wave; return v; }

__device__ __forceinline__ void transpose_item(const float* W, int ldw, bf16* WT, int ldt, int k0, int n0, LAS float* scr, int lane) {
    float tv[32];
#pragma unroll
    for (int i = 0; i < 32; ++i) { const int kk = 2 * i + (lane >> 5); tv[i] = W[(size_t)(k0 + kk) * ldw + n0 + (lane & 31)]; }
#pragma unroll
    for (int i = 0; i < 32; ++i) { const int kk = 2 * i + (lane >> 5); scr[kk * 33 + (lane & 31)] = tv[i]; }
    LDS_WAIT(); asm volatile("" ::: "memory");
    const int c = lane & 7;
#pragma unroll
    for (int j = 0; j < 4; ++j) { const int n = (lane >> 3) + 8 * j; const LAS float* s = scr + (8 * c) * 33 + n;
        u32x4 o; o.x = cvt_pk_bf16(s[0 * 33], s[1 * 33]); o.y = cvt_pk_bf16(s[2 * 33], s[3 * 33]); o.z = cvt_pk_bf16(s[4 * 33], s[5 * 33]); o.w = cvt_pk_bf16(s[6 * 33], s[7 * 33]);
        *(u32x4*)(WT + (size_t)(n0 + n) * ldt + k0 + 8 * c) = o; }
    LDS_WAIT(); asm volatile("" ::: "memory");
}
__device__ __forceinline__ bool transpose_group(int& r, const float* src, size_t sstr, int K, int N, bf16* dst, size_t dstr, int ldt, int cnt, LAS float* scr, int lane) {
    const int per = (K / 64) * (N / 32);
    if (r >= per * cnt) { r -= per * cnt; return false; }
    const int mi = r / per, it = r % per, nblk = N / 32, kb = it / nblk, nb = it % nblk;
    transpose_item(src + (size_t)mi * sstr, N, dst + (size_t)mi * dstr, ldt, 64 * kb, 32 * nb, scr, lane);
    return true;
}

__device__ __forceinline__ void prep_rows(const Ctx& F0, const float* Xa, const float* Xb, int r0, int r1, const float* gm, bf16* XG, u64* st, const float* part, const float* pgate, float* Xw) {
    const LaneV F = lane_view(F0);
    f32x4 v[4][2], vn[4][2];
#define PR_LOAD(dst, r_) do { const float* xr_ = ((r_) < TX ? Xa + (size_t)(r_) * D : Xb + (size_t)((r_) - TX) * D) + 8 * F.lane; \
        _Pragma("unroll") for (int q = 0; q < 4; ++q) _Pragma("unroll") for (int e = 0; e < 2; ++e) dst[q][e] = *(const f32x4*)(xr_ + 512 * q + 4 * e); } while (0)
    if (r0 + F.gw < r1) PR_LOAD(v, r0 + F.gw);
    for (int r = r0 + F.gw; r < r1; r += F0.NGW) {
        const int rn = r + F0.NGW;
        if (rn < r1) PR_LOAD(vn, rn);
        const bool isx = r < TX; const int j = isx ? (r >> 13) : 4; const float* mp = gm + (size_t)j * D;
        if (!isx && part) {
            const float* pr = part + (size_t)(r - TX) * D + 8 * F.lane;
#pragma unroll
            for (int q = 0; q < 4; ++q)
#pragma unroll
                for (int e = 0; e < 2; ++e) { f32x4 a = *(const f32x4*)(pr + 512 * q + 4 * e);
#pragma unroll
                    for (int sp = 1; sp < 8; ++sp) a += *(const f32x4*)(pr + (size_t)sp * TC * D + 512 * q + 4 * e);
                    v[q][e] += *(const f32x4*)(pgate + 8 * F.lane + 512 * q + 4 * e) * a;
                    *(f32x4*)(Xw + (size_t)r * D + 8 * F.lane + 512 * q + 4 * e) = v[q][e]; }
        }
        float ss = 0.f;
#pragma unroll
        for (int q = 0; q < 4; ++q)
#pragma unroll
            for (int e = 0; e < 2; ++e) ss += (v[q][e].x * v[q][e].x + v[q][e].y * v[q][e].y) + (v[q][e].z * v[q][e].z + v[q][e].w * v[q][e].w);
        ss = wave_sum(ss);
        if (F.lane == 0) st[r] = (u64)(ss * SS_FIX);
#pragma unroll
        for (int q = 0; q < 4; ++q) { const int c = 8 * F.lane + 512 * q; const f32x4 o0 = v[q][0] * *(const f32x4*)(mp + c), o1 = v[q][1] * *(const f32x4*)(mp + c + 4);
            u32x4 w; w.x = cvt_pk_bf16(o0.x, o0.y); w.y = cvt_pk_bf16(o0.z, o0.w); w.z = cvt_pk_bf16(o1.x, o1.y); w.w = cvt_pk_bf16(o1.z, o1.w);
            *(u32x4*)(XG + (size_t)r * D + c) = w; }
#pragma unroll
        for (int q = 0; q < 4; ++q)
#pragma unroll
            for (int e = 0; e < 2; ++e) v[q][e] = vn[q][e];
    }
#undef PR_LOAD
}
__device__ __forceinline__ void final_norm_rows(const Ctx& F0, const float* X, const float* gain, float* out) {
    const LaneV F = lane_view(F0);
    f32x4 v[4][2], vn[4][2];
#define FN_LOAD(dst, r_) do { const float* xr_ = X + (size_t)(r_) * D + 8 * F.lane; \
        _Pragma("unroll") for (int q = 0; q < 4; ++q) _Pragma("unroll") for (int e = 0; e < 2; ++e) dst[q][e] = *(const f32x4*)(xr_ + 512 * q + 4 * e); } while (0)
    if (F.gw < TX) FN_LOAD(v, F.gw);
    for (int r = F.gw; r < TX; r += F0.NGW) {
        const int rn = r + F0.NGW;
        if (rn < TX) FN_LOAD(vn, rn);
        float ss = 0.f;
#pragma unroll
        for (int q = 0; q < 4; ++q)
#pragma unroll
            for (int e = 0; e < 2; ++e) ss += (v[q][e].x * v[q][e].x + v[q][e].y * v[q][e].y) + (v[q][e].z * v[q][e].z + v[q][e].w * v[q][e].w);
        const float rs = 1.0f / sqrtf(wave_sum(ss) * (1.0f / D) + EPS);
#pragma unroll
        for (int q = 0; q < 4; ++q)
#pragma unroll
            for (int e = 0; e < 2; ++e) { const int c = 8 * F.lane + 512 * q + 4 * e; *(f32x4*)(out + (size_t)r * D + c) = (v[q][e] * rs) * *(const f32x4*)(gain + c); }
#pragma unroll
        for (int q = 0; q < 4; ++q)
#pragma unroll
            for (int e = 0; e < 2; ++e) v[q][e] = vn[q][e];
    }
#undef FN_LOAD
}
struct MidRow { u32x4 q; u32x2 kv; unsigned short rp; u32x2 w[30]; };
__device__ __forceinline__ void mid_load(MidRow& R, const bf16* P, int r, int lane) {
    const bf16* pr = P + (size_t)r * INWP; const bool isx = r < TX; const int t = isx ? (r & (SEQ - 1)) : ((r - TX) & (CTXL - 1)); const int n = isx ? SEQ : CTXL;
    R.q = *(const u32x4*)(pr + 8 * lane); R.kv = *(const u32x2*)(pr + QR + 4 * lane); R.rp = *(const unsigned short*)(pr + QR + KVR + lane);
    const bf16* seq0 = pr - (size_t)t * INWP + MLA_IN + 4 * lane;
#pragma unroll
    for (int g = 0; g < 4; ++g) { const int hw = 1 << g;
#pragma unroll
        for (int k = 0; k < 16; ++k) if (k < 2 * hw) { const int tt = t - hw + k; const int tc = tt < 0 ? 0 : (tt >= n ? n - 1 : tt); R.w[2 * hw - 2 + k] = *(const u32x2*)(seq0 + (size_t)tc * INWP + g * 256); } }
}
__device__ __forceinline__ void mid_compute(const MidRow& R, int r, int lane, const f32x4 qg0, const f32x4 qg1, const f32x4 kg0, const f32x2* rope, bf16* QN, bf16* KVN, bf16* KB, bf16* POOLED) {
    const bool isx = r < TX; const int b = isx ? (r >> 13) : ((r - TX) >> 8); const int t = isx ? (r & (SEQ - 1)) : ((r - TX) & (CTXL - 1)); const int n = isx ? SEQ : CTXL;
    { const u32x4 w = R.q; float q[8] = {bflo(w.x), bfhi(w.x), bflo(w.y), bfhi(w.y), bflo(w.z), bfhi(w.z), bflo(w.w), bfhi(w.w)}; float ss = 0.f;
#pragma unroll
      for (int e = 0; e < 8; ++e) ss += q[e] * q[e];
      const float rs = 1.0f / sqrtf(wave_sum(ss) * (1.0f / QR) + EPS); const f32x4 g0 = qg0, g1 = qg1;
      u32x4 o; o.x = cvt_pk_bf16(q[0] * rs * g0.x, q[1] * rs * g0.y); o.y = cvt_pk_bf16(q[2] * rs * g0.z, q[3] * rs * g0.w); o.z = cvt_pk_bf16(q[4] * rs * g1.x, q[5] * rs * g1.y); o.w = cvt_pk_bf16(q[6] * rs * g1.z, q[7] * rs * g1.w);
      *(u32x4*)(QN + (size_t)r * QR + 8 * lane) = o; }
    { const u32x2 w = R.kv; float q[4] = {bflo(w.x), bfhi(w.x), bflo(w.y), bfhi(w.y)}; float ss = (q[0] * q[0] + q[1] * q[1]) + (q[2] * q[2] + q[3] * q[3]);
      const float rs = 1.0f / sqrtf(wave_sum(ss) * (1.0f / KVR) + EPS); const f32x4 g0 = kg0;
      u32x2 o; o.x = cvt_pk_bf16(q[0] * rs * g0.x, q[1] * rs * g0.y); o.y = cvt_pk_bf16(q[2] * rs * g0.z, q[3] * rs * g0.w);
      *(u32x2*)(KVN + (size_t)r * KVR + 4 * lane) = o; }
    { float x = __uint_as_float((unsigned)R.rp << 16); const float xp = __shfl_xor(x, 16);
      if (isx) { const int pos = (lane >> 5) ? (t & 63) : (t >> 6); const f32x2 cs = rope[pos * 16 + (lane & 15)]; x = ((lane >> 4) & 1) ? (x * cs.x + xp * cs.y) : (x * cs.x - xp * cs.y); }
      const bf16 hv = (bf16)(cvt_pk_bf16(x, 0.f) & 0xffffu); bf16* kp = KB + ((size_t)b * NKEY + (isx ? CTXL + t : t)) * (NH * DQK) + DN + lane;
#pragma unroll
      for (int h = 0; h < NH; ++h) kp[h * DQK] = hv; }
#pragma unroll
    for (int g = 0; g < 4; ++g) { const int hw = 1 << g; float s[4] = {0.f, 0.f, 0.f, 0.f}; u32x2 wself = (u32x2){0u, 0u};
#pragma unroll
        for (int k = 0; k < 16; ++k) if (k < 2 * hw) { const int tt = t - hw + k; const float ok = (tt >= 0 && tt < n) ? 1.0f : 0.0f; const u32x2 wv = R.w[2 * hw - 2 + k];
            s[0] += ok * bflo(wv.x); s[1] += ok * bfhi(wv.x); s[2] += ok * bflo(wv.y); s[3] += ok * bfhi(wv.y); if (k == hw) wself = wv; }
        const int lo = t - hw < 0 ? 0 : t - hw, hi = t + hw > n ? n : t + hw; const float inv = 1.0f / (float)(hi - lo);
        u32x2 o; o.x = cvt_pk_bf16(s[0] * inv - bflo(wself.x), s[1] * inv - bfhi(wself.x)); o.y = cvt_pk_bf16(s[2] * inv - bflo(wself.y), s[3] * inv - bfhi(wself.y));
        *(u32x2*)(POOLED + (size_t)r * PW + g * 256 + 4 * lane) = o; }
}
__device__ __forceinline__ void mid_rows(const Ctx& F0, const bf16* P, int M, const float* qg, const float* kvg, const f32x2* rope, bf16* QN, bf16* KVN, bf16* KB, bf16* POOLED) {
    const LaneV F = lane_view(F0); const int lane = F.lane, step = F0.NGW;
    const f32x4 qg0 = *(const f32x4*)(qg + 8 * lane), qg1 = *(const f32x4*)(qg + 8 * lane + 4), kg0 = *(const f32x4*)(kvg + 4 * lane);
    MidRow A, B;
    int r = F.gw;
    if (r < M) mid_load(A, P, r, lane);
    for (; r < M; r += 2 * step) {
        if (r + step < M) mid_load(B, P, r + step, lane);
        __builtin_amdgcn_sched_barrier(0);
        mid_compute(A, r, lane, qg0, qg1, kg0, rope, QN, KVN, KB, POOLED);
        __builtin_amdgcn_sched_barrier(0);
        if (r + 2 * step < M) mid_load(A, P, r + 2 * step, lane);
        __builtin_amdgcn_sched_barrier(0);
        if (r + step < M) mid_compute(B, r + step, lane, qg0, qg1, kg0, rope, QN, KVN, KB, POOLED);
        __builtin_amdgcn_sched_barrier(0);
    }
}

struct Args { const float* in[20]; float* out; unsigned char* ws; };
#define KARG() ({ const __attribute__((address_space(4))) Args* k_ = (const __attribute__((address_space(4))) Args*)__builtin_amdgcn_kernarg_segment_ptr(); asm volatile("" : "+s"(k_)); k_; })
#define KIN(i) ({ const GAS float* q_ = (const GAS float*)(KARG()->in[i]); asm volatile("" : "+s"(q_)); (const float*)q_; })
#define KOUT() ({ GAS float* q_ = (GAS float*)(KARG()->out); asm volatile("" : "+s"(q_)); (float*)q_; })
enum { I_X = 0, I_C, I_CTX, I_CCTX, I_WMOD, I_BMOD, I_NORM1, I_NORM2, I_WIN, I_QNORM, I_WUQ, I_KVNORM, I_WUKV, I_WPOOL, I_PSCALE, I_WOE, I_WOO, I_W1, I_W2, I_FNORM };

__device__ __forceinline__ void prologue(const Ctx& F0) {
    unsigned char* ws; { GAS unsigned char* p_ = (GAS unsigned char*)KARG()->ws; asm volatile("" : "+s"(p_)); ws = (unsigned char*)p_; }
    struct PF { LAS unsigned char* lds; int tid, lane, wave, gw, NGW, gt, NGT; };
#define PFV() ({ PF f_; const LaneV v_ = lane_view(F0); f_.lds = F0.lds; f_.tid = v_.tid; f_.lane = v_.lane; f_.wave = v_.wave; f_.gw = v_.gw; f_.NGW = F0.NGW; f_.gt = F0.vcu * 512 + v_.tid; f_.NGT = F0.G * 512; f_; })
    LAS float* sl = (LAS float*)(F0.lds + SILU_OFF);
    { const PF F = PFV(); for (int i = F.tid; i < NMOD * D; i += 512) { const float v = i < NB * D ? KIN(I_C)[i] : KIN(I_CCTX)[i - NB * D]; sl[i] = v / (1.0f + __expf(-v)); } }
    __syncthreads();
    { const PF F = PFV(); float* PART = (float*)(ws + WS_PART); const float* wm = KIN(I_WMOD);
      for (int it = F.gw; it < DEPTH * 48 * 32; it += F.NGW) { const int l = it / 1536, r = it % 1536, nc = r % 48, kc = r / 48; const int n = nc * 256 + 4 * F.lane;
          f32x4 acc[NMOD];
#pragma unroll
          for (int j = 0; j < NMOD; ++j) acc[j] = (f32x4){0.f, 0.f, 0.f, 0.f};
          const float* wp = wm + ((size_t)l * D + kc * 64) * MODW + n;
          for (int kk = 0; kk < 64; kk += 16) { f32x4 w[16];
#pragma unroll
              for (int u = 0; u < 16; ++u) w[u] = *(const f32x4*)(wp + (size_t)(kk + u) * MODW);
#pragma unroll
              for (int j = 0; j < NMOD; ++j)
#pragma unroll
                  for (int u4 = 0; u4 < 4; ++u4) { const f32x4 s = *(const LAS f32x4*)(sl + j * D + kc * 64 + kk + 4 * u4); acc[j] += w[4 * u4] * s.x + w[4 * u4 + 1] * s.y + w[4 * u4 + 2] * s.z + w[4 * u4 + 3] * s.w; } }
#pragma unroll
          for (int j = 0; j < NMOD; ++j) *(f32x4*)(PART + (((size_t)kc * DEPTH + l) * NMOD + j) * MODW + n) = acc[j]; } }
    { const PF F = PFV(); LAS float* scr = (LAS float*)(F.lds + F.wave * SCR_PER_WAVE);
      constexpr int NIT = 2 * (32 * 58) + 2 * (8 * 48) + 2 * (4 * 64) + 8 * (4 * 8) + 2 * (32 * 64) + 2 * (32 * 64) + 4 * (32 * 256) + 4 * (128 * 64);
      for (int it = F.gw; it < NIT; it += F.NGW) { int r = it;
          if (transpose_group(r, KIN(I_WIN), (size_t)D * INW, D, INW, (bf16*)(ws + WS_WIN), (size_t)INWP * D, D, 2, scr, F.lane)) continue;
          if (transpose_group(r, KIN(I_WUQ), (size_t)QR * NH * DQK, QR, NH * DQK, (bf16*)(ws + WS_WUQ), (size_t)NH * DQK * QR, QR, 2, scr, F.lane)) continue;
          if (transpose_group(r, KIN(I_WUKV), (size_t)KVR * NH * 256, KVR, NH * 256, (bf16*)(ws + WS_WUKV), (size_t)NH * 256 * KVR, KVR, 2, scr, F.lane)) continue;
          if (transpose_group(r, KIN(I_WPOOL), (size_t)256 * 256, 256, 256, (bf16*)(ws + WS_WPOOL), (size_t)256 * 256, 256, 8, scr, F.lane)) continue;
          if (transpose_group(r, KIN(I_WOE), (size_t)D * D, D, D, (bf16*)(ws + WS_WOE), (size_t)D * D, D, 2, scr, F.lane)) continue;
          if (transpose_group(r, KIN(I_WOO), (size_t)D * D, D, D, (bf16*)(ws + WS_WOO), (size_t)D * D, D, 2, scr, F.lane)) continue;
          if (transpose_group(r, KIN(I_W1), (size_t)D * DFF, D, DFF, (bf16*)(ws + WS_W1), (size_t)DFF * D, D, 4, scr, F.lane)) continue;
          transpose_group(r, KIN(I_W2), (size_t)DFF * D, DFF, D, (bf16*)(ws + WS_W2), (size_t)D * DFF, DFF, 4, scr, F.lane); } }
    { const PF F = PFV(); const int gt = F.gt, NGT = F.NGT; constexpr int PADV = (INWP - INW) * D * 2 / 16;
      for (int i = gt; i < 2 * PADV; i += NGT) { const int li = i / PADV, p = i % PADV; *(u32x4*)(ws + WS_WIN + (size_t)li * INWP * D * 2 + (size_t)INW * D * 2 + (size_t)p * 16) = (u32x4){0u, 0u, 0u, 0u}; } }
    { const PF F = PFV(); const int gt = F.gt, NGT = F.NGT;
    for (int i = gt; i < 128 * 16; i += NGT) { const int pos = i >> 4, f = i & 15; const float inv = powf(10000.0f, -2.0f * (float)f / 32.0f); const float ang = (float)pos * inv; ((f32x2*)(ws + WS_ROPE))[i] = (f32x2){cosf(ang), sinf(ang)}; } }
    { const PF F = PFV(); const int gt = F.gt, NGT = F.NGT;
    for (int i = gt; i < 1024 * 512; i += NGT) { const int row = i >> 9, c = i & 511, ri = row >> 9, m = row & 511; float sn, cs; sincospif((float)((c * m) & 511) * (1.0f / 256.0f), &sn, &cs);
        const float v = (ri ? -sn : cs) * 0.04419417382415922f; ((bf16*)(ws + WS_BC))[i] = (bf16)(cvt_pk_bf16(v, 0.f) & 0xffffu); } }
    { const PF F = PFV(); const int gt = F.gt, NGT = F.NGT;
    for (int i = gt; i < 256 * 512; i += NGT) { const int k = i >> 9, col = i & 511, ri = col >> 8, j = col & 255; float sn, cs; sincospif((float)((j * k) & 255) * (1.0f / 128.0f), &sn, &cs);
        const float v = (ri ? sn : cs) * 0.0625f; ((bf16*)(ws + WS_WC))[i] = (bf16)(cvt_pk_bf16(v, 0.f) & 0xffffu); } }
    { const PF F = PFV(); const int gt = F.gt, NGT = F.NGT;
    for (int i = gt; i < 256 * 256; i += NGT) { const int c = i >> 8, kk = i & 255, k1 = c >> 3, ro = (c >> 2) & 1, js = c & 3, js2 = kk >> 6, ri = (kk >> 5) & 1, j1 = kk & 31; float sn, cs; sincospif((float)((j1 * k1) & 31) * (1.0f / 16.0f), &sn, &cs);
        float v = (ro == ri) ? cs : (ro == 0 ? sn : -sn); v = (js == js2) ? v * 0.17677669529663687f : 0.f; ((bf16*)(ws + WS_W1BD))[i] = (bf16)(cvt_pk_bf16(v, 0.f) & 0xffffu); } }
#undef PFV
}
__device__ __forceinline__ void mod_reduce(const Ctx& F0) {
    const LaneV F = lane_view(F0); unsigned char* ws; { GAS unsigned char* p_ = (GAS unsigned char*)KARG()->ws; asm volatile("" : "+s"(p_)); ws = (unsigned char*)p_; }
    const float* PART = (const float*)(ws + WS_PART); float* MOD = (float*)(ws + WS_MOD); float* GM = (float*)(ws + WS_GM); const float* bm = KIN(I_BMOD);
    for (int i = F0.vcu * 512 + F.tid; i < DEPTH * NMOD * MODW / 4; i += F0.G * 512) { const int e = i * 4, l = e / (NMOD * MODW), j = (e / MODW) % NMOD, n = e % MODW;
        f32x4 a = *(const f32x4*)(bm + (size_t)l * MODW + n);
        for (int kc = 0; kc < 32; ++kc) a += *(const f32x4*)(PART + (size_t)kc * DEPTH * NMOD * MODW + e);
        *(f32x4*)(MOD + e) = a;
        const int chunk = n / D, c = n % D;
        if (chunk == 1 || chunk == 4) { const int which = chunk == 4; const f32x4 g = *(const f32x4*)((which ? KIN(I_NORM2) : KIN(I_NORM1)) + (size_t)l * D + c);
            *(f32x4*)(GM + (((size_t)l * 2 + which) * NMOD + j) * D + c) = g * (a + 1.0f); } }
}
__device__ __forceinline__ void bias_rows(const Ctx& F0) {
    const LaneV F = lane_view(F0); unsigned char* ws; { GAS unsigned char* p_ = (GAS unsigned char*)KARG()->ws; asm volatile("" : "+s"(p_)); ws = (unsigned char*)p_; }
    const float* MOD = (const float*)(ws + WS_MOD); LAS float* shl = (LAS float*)F0.lds;
    for (int set = 0; set < 8; ++set) {
        const bf16* wbase; const float* sh; float* out; int nrows, ostride;
        if (set < 2) { const int li = set; wbase = (const bf16*)(ws + WS_WIN) + (size_t)li * INWP * D; sh = MOD + (size_t)(2 * li) * NMOD * MODW; out = (float*)(ws + WS_BIASP) + (size_t)li * NMOD * INWP; nrows = INWP; ostride = INWP; }
        else if (set < 6) { const int l = set - 2; wbase = (const bf16*)(ws + WS_W1) + (size_t)l * DFF * D; sh = MOD + (size_t)l * NMOD * MODW + 3 * D; out = (float*)(ws + WS_BIASA) + (size_t)l * NMOD * DFF; nrows = DFF; ostride = DFF; }
        else { const int li = set - 6; wbase = (const bf16*)(ws + WS_BC); sh = MOD + (size_t)(2 * li + 1) * NMOD * MODW; out = (float*)(ws + WS_BIASF) + (size_t)li * NMOD * 4096; nrows = 4096; ostride = 4096; }
        __syncthreads();
        for (int i = F.tid; i < NMOD * D / 4; i += 512) { const int j = i / (D / 4), c = (i % (D / 4)) * 4; *(LAS f32x4*)(shl + j * D + c) = *(const f32x4*)(sh + (size_t)j * MODW + c); }
        __syncthreads();
        if (set < 6) {
            for (int n0 = F.gw; n0 < nrows; n0 += 4 * F0.NGW) { u32x4 w[4][4];
#pragma unroll
                for (int i = 0; i < 4; ++i) { const int n = n0 + i * F0.NGW; if (n < nrows) { const bf16* wrow = wbase + (size_t)n * D + 8 * F.lane;
#pragma unroll
                    for (int q = 0; q < 4; ++q) w[i][q] = *(const u32x4*)(wrow + 512 * q); } }
                __builtin_amdgcn_sched_barrier(0);
#pragma unroll
                for (int i = 0; i < 4; ++i) { const int n = n0 + i * F0.NGW; if (n < nrows) {
                    float acc[NMOD];
#pragma unroll
                    for (int j = 0; j < NMOD; ++j) acc[j] = 0.f;
#pragma unroll
                    for (int q = 0; q < 4; ++q) { const float wv[8] = {bflo(w[i][q].x), bfhi(w[i][q].x), bflo(w[i][q].y), bfhi(w[i][q].y), bflo(w[i][q].z), bfhi(w[i][q].z), bflo(w[i][q].w), bfhi(w[i][q].w)};
#pragma unroll
                        for (int j = 0; j < NMOD; ++j) { const f32x4 s0 = *(const LAS f32x4*)(shl + j * D + 8 * F.lane + 512 * q), s1 = *(const LAS f32x4*)(shl + j * D + 8 * F.lane + 512 * q + 4);
                            acc[j] += (wv[0] * s0.x + wv[1] * s0.y) + (wv[2] * s0.z + wv[3] * s0.w) + (wv[4] * s1.x + wv[5] * s1.y) + (wv[6] * s1.z + wv[7] * s1.w); } }
#pragma unroll
                    for (int j = 0; j < NMOD; ++j) { const float t = wave_sum(acc[j]); if (F.lane == 0) out[(size_t)j * ostride + n] = t; } } }
                __builtin_amdgcn_sched_barrier(0); }
        } else {
            for (int n0 = F.gw; n0 < nrows; n0 += 4 * F0.NGW) { u32x4 w[4];
#pragma unroll
                for (int i = 0; i < 4; ++i) { const int n = n0 + i * F0.NGW; if (n < nrows) w[i] = *(const u32x4*)(wbase + (size_t)(n & 1023) * 512 + 8 * F.lane); }
                __builtin_amdgcn_sched_barrier(0);
#pragma unroll
                for (int i = 0; i < 4; ++i) { const int n = n0 + i * F0.NGW; if (n < nrows) { const int g = n >> 10;
                    const float wv[8] = {bflo(w[i].x), bfhi(w[i].x), bflo(w[i].y), bfhi(w[i].y), bflo(w[i].z), bfhi(w[i].z), bflo(w[i].w), bfhi(w[i].w)};
#pragma unroll
                    for (int j = 0; j < NMOD; ++j) { const f32x4 s0 = *(const LAS f32x4*)(shl + j * D + g * 512 + 8 * F.lane), s1 = *(const LAS f32x4*)(shl + j * D + g * 512 + 8 * F.lane + 4);
                        float a = (wv[0] * s0.x + wv[1] * s0.y) + (wv[2] * s0.z + wv[3] * s0.w) + (wv[4] * s1.x + wv[5] * s1.y) + (wv[6] * s1.z + wv[7] * s1.w);
                        a = wave_sum(a); if (F.lane == 0) out[(size_t)j * ostride + n] = a; } } }
                __builtin_amdgcn_sched_barrier(0); }
        }
    }
    __syncthreads();
}
struct MapPool {
    const char* A; const char* B; int nM;
    __device__ __forceinline__ int total() const { return nM * 4; }
    __device__ __forceinline__ void get(int L, pg8::Unit& u) const { const int pm = L >> 2, g = L & 3; u.pm = pm; u.pn = g; u.a = A + (size_t)pm * 256 * (PW * 2) + g * 512; u.b = B + (size_t)g * 256 * 256 * 2; }
};
struct MapF1 {
    const char* Bc; const char* H;
    __device__ __forceinline__ int total() const { return NB * 4 * 32 * 4; }
    __device__ __forceinline__ void get(int L, pg8::Unit& u) const { const int pmr = L & 3, jt = (L >> 2) & 31, g = (L >> 7) & 3, b = L >> 9;
        u.a = Bc + (size_t)pmr * 256 * 1024; u.b = H + ((size_t)b * SEQ + jt * 8) * (D * 2) + g * 1024; u.pm = (b * 4 + g) * 4 + pmr; u.pn = jt; }
};
struct MapYTC {
    const char* Bc; const char* H;
    __device__ __forceinline__ int total() const { return NB * 4 * 4; }
    __device__ __forceinline__ void get(int L, pg8::Unit& u) const { const int pmr = L & 3, g = (L >> 2) & 3, b = L >> 4;
        u.a = Bc + (size_t)pmr * 256 * 1024; u.b = H + ((size_t)TX + b * CTXL) * (D * 2) + g * 1024; u.pm = b * 8 + g * 2 + (pmr & 1); u.pn = pmr >> 1; }
};
struct MapF3 {
    const char* WC; const char* G;
    __device__ __forceinline__ int total() const { return NB * 32 * 8; }
    __device__ __forceinline__ void get(int L, pg8::Unit& u) const { const int pn = L & 7, bk = L >> 3; u.a = WC; u.b = G + ((size_t)bk * D + pn * 256) * 1024; u.pm = bk; u.pn = pn; }
};
struct MapFC {
    const char* WC; const char* YTC;
    __device__ __forceinline__ int total() const { return NB * 8; }
    __device__ __forceinline__ void get(int L, pg8::Unit& u) const { const int b = L >> 3, pn = L & 7; u.a = WC; u.b = YTC + ((size_t)b * D + pn * 256) * 1024; u.pm = 128 + b; u.pn = pn; }
};

__global__ void __launch_bounds__(512, 2) fwd(Args args) {
    extern __shared__ __attribute__((aligned(16))) unsigned char lds_raw[];
    Ctx F; F.lds = (LAS unsigned char*)lds_raw;
    F.G = gridDim.x; { const int bx = blockIdx.x; F.vcu = (F.G % 8 == 0) ? (bx % 8) * (F.G / 8) + bx / 8 : bx; }
    F.NGW = F.G * 8;
    for (int u = threadIdx.x; u < (LDS_BYTES - LDSCTL_OFF) / 4; u += 512) ((LAS unsigned*)(F.lds + LDSCTL_OFF))[u] = 0u;
    __syncthreads();
    volatile LAS unsigned* MISC = (volatile LAS unsigned*)(F.lds + MISC_OFF);
    (void)xcd_barrier_post((unsigned*)(args.ws + WS_CTL) + CW_BAR, MISC + 8);
#define bx ({ int b_ = (int)blockIdx.x; asm volatile("" : "+s"(b_)); b_; })
#define WSL() ({ GAS unsigned char* p_ = (GAS unsigned char*)KARG()->ws; asm volatile("" : "+s"(p_)); (unsigned char*)p_; })
#define GRID_BAR() do { XcdBarrier b_; b_.bar = (unsigned*)(WSL() + WS_CTL) + CW_BAR; b_.x = xb_xcc_id(); b_.st = (volatile LAS unsigned*)(F.lds + MISC_OFF) + 8; xcd_barrier(b_); } while (0)
#define ROT(k) ({ int c_ = bx + F.G - (k); c_ = (F.G > (k) && F.G % 8 == 0) ? (c_ >= F.G ? c_ - F.G : c_) : bx; c_; })
#define XP(w) ((float*)((w) + WS_X))
#define HP(w) ((bf16*)((w) + WS_H))
#define CATP(w) ((bf16*)((w) + WS_CAT))
#define MODP(w, l) ((const float*)((w) + WS_MOD) + (size_t)(l) * NMOD * MODW)
#define STP(w, l, which) ((u64*)((w) + WS_STATS) + (size_t)((l) * 2 + (which)) * T)
#define GMP(w, l, which) ((const float*)((w) + WS_GM) + (size_t)((l) * 2 + (which)) * NMOD * D)

    prologue(F);
    GRID_BAR();
    mod_reduce(F);
    GRID_BAR();
    bias_rows(F);
    { unsigned char* ws = WSL(); prep_rows(F, KIN(I_X), KIN(I_CTX), 0, T, GMP(ws, 0, 0), HP(ws), STP(ws, 0, 0), nullptr, nullptr, nullptr); }
    GRID_BAR();

    for (int l = 0; l < DEPTH; ++l) {
        const bool even = (l & 1) == 0; const int li = l >> 1;
        const bool ctx_in = l <= 2, ctx_out = l <= 1;
        const int Min = ctx_in ? T : TX, nMin = Min / 256, Mout = ctx_out ? T : TX, nMout = Mout / 256;
        if (even) {
            {
                unsigned char* ws = WSL();
                pg8::Strided<pg8::MapStd> S{{(const char*)HP(ws), (const char*)(ws + WS_WIN + (size_t)li * INWP * D * 2), 256l * D * 2, 256l * D * 2, nMin, INWP / 256}, F.G, bx};
                pg8::gemm_phase(F.lds, pg8::Geo{D, D * 2, D * 2}, S, pg8::EpiNormStore{(bf16*)(ws + WS_P), INWP, STP(ws, l, 0), (const float*)(ws + WS_BIASP) + (size_t)li * NMOD * INWP, INWP});
            }
            GRID_BAR();
            { unsigned char* ws = WSL();
              mid_rows(F, (const bf16*)(ws + WS_P), Min, KIN(I_QNORM) + (size_t)li * QR, KIN(I_KVNORM) + (size_t)li * KVR, (const f32x2*)(ws + WS_ROPE), (bf16*)(ws + WS_QN), (bf16*)(ws + WS_KVN), (bf16*)(ws + WS_KB), (bf16*)(ws + WS_POOLED)); }
            GRID_BAR();
            {
                unsigned char* ws = WSL();
                pg8::Strided<pg8::MapStd> S{{(const char*)(ws + WS_QN), (const char*)(ws + WS_WUQ + (size_t)li * NH * DQK * QR * 2), 256l * QR * 2, 256l * QR * 2, nMout, NH * DQK / 256}, F.G, bx};
                pg8::gemm_phase(F.lds, pg8::Geo{QR, QR * 2, QR * 2}, S, pg8::EpiQ{(bf16*)(ws + WS_Q), (const f32x2*)(ws + WS_ROPE)});
            }
            {
                unsigned char* ws = WSL();
                pg8::Strided<pg8::MapStd> S{{(const char*)(ws + WS_KVN), (const char*)(ws + WS_WUKV + (size_t)li * NH * 256 * KVR * 2), 256l * KVR * 2, 256l * KVR * 2, nMin, NH}, F.G, ROT(32)};
                pg8::gemm_phase(F.lds, pg8::Geo{KVR, KVR * 2, KVR * 2}, S, pg8::EpiKV{(bf16*)(ws + WS_KB), (bf16*)(ws + WS_VB)});
            }
            {
                unsigned char* ws = WSL();
                pg8::Strided<MapPool> S{{(const char*)(ws + WS_POOLED), (const char*)(ws + WS_WPOOL + (size_t)li * 4 * 256 * 256 * 2), nMout}, F.G, ROT(64)};
                pg8::gemm_phase(F.lds, pg8::Geo{256, PW * 2, 256 * 2}, S, pg8::EpiPool{CATP(ws), KIN(I_PSCALE) + (size_t)li * PW});
            }
            GRID_BAR();
            {
                unsigned char* ws = WSL();
                const bf16* Q = (const bf16*)(ws + WS_Q); const bf16* KB = (const bf16*)(ws + WS_KB); const bf16* VB = (const bf16*)(ws + WS_VB); bf16* CAT = CATP(ws);
                const int nun = ctx_out ? 1024 + 32 : 1024;
                for (int i = 0;; ++i) { const int id = i * F.G + F.vcu; if (id >= nun) break;
                    int row0, b, h, seq;
                    if (id < 1024) { const int bh = id >> 5, qb = id & 31; b = bh >> 3; h = bh & 7; row0 = b * SEQ + qb * 256; seq = NKEY; }
                    else { const int c = id - 1024; b = c >> 3; h = c & 7; row0 = TX + b * CTXL; seq = CTXL; }
                    att::attn_unit(Q + (size_t)row0 * (NH * DQK) + h * DQK, KB + (size_t)b * NKEY * (NH * DQK) + h * DQK, VB + (size_t)b * NKEY * (NH * DV) + h * DV,
                                   CAT + (size_t)row0 * D + h * DV, seq, (LAS char*)F.lds); }
            }
            GRID_BAR();
        } else {
            {
                unsigned char* ws = WSL();
                pg8::Strided<MapF1> S{{(const char*)(ws + WS_BC), (const char*)HP(ws)}, F.G, bx};
                pg8::gemm_phase<pg8::EpiYt, pg8::Strided<MapF1>, true, true>(F.lds, pg8::Geo{512, 1024, D * 2}, S, pg8::EpiYt{(bf16*)(ws + WS_YT), STP(ws, l, 0), (const float*)(ws + WS_BIASF) + (size_t)li * NMOD * 4096});
            }
            if (ctx_out) {
                unsigned char* ws = WSL();
                pg8::Strided<MapYTC> S{{(const char*)(ws + WS_BC), (const char*)HP(ws)}, F.G, bx};
                pg8::gemm_phase(F.lds, pg8::Geo{512, 1024, D * 2}, S, pg8::EpiYtc{(bf16*)(ws + WS_YTC), STP(ws, l, 0), (const float*)(ws + WS_BIASF) + (size_t)li * NMOD * 4096});
            }
            GRID_BAR();
            {
                unsigned char* ws = WSL();
                pg8::Strided<pg8::MapStd> S{{(const char*)(ws + WS_YT), (const char*)(ws + WS_W1BD), 256l * 512, 0l, NB * D * 64 / 256, 1}, F.G, bx};
                pg8::gemm_phase(F.lds, pg8::Geo{256, 512, 512}, S, pg8::EpiF2{(bf16*)(ws + WS_G)});
            }
            GRID_BAR();
            {
                unsigned char* ws = WSL();
                pg8::Strided<MapF3> S{{(const char*)(ws + WS_WC), (const char*)(ws + WS_G)}, F.G, bx};
                pg8::gemm_phase(F.lds, pg8::Geo{512, 1024, 1024}, S, pg8::EpiF3{CATP(ws)});
            }
            if (ctx_out) {
                unsigned char* ws = WSL();
                pg8::Strided<MapFC> S{{(const char*)(ws + WS_WC), (const char*)(ws + WS_YTC)}, F.G, bx};
                pg8::gemm_phase(F.lds, pg8::Geo{2 * CTXL, 2 * CTXL * 2, 2 * CTXL * 2}, S, pg8::EpiStore<0>{CATP(ws), D});
            }
            GRID_BAR();
        }
        {
            unsigned char* ws = WSL();
            const char* Wo = even ? (const char*)(ws + WS_WOE + (size_t)li * D * D * 2) : (const char*)(ws + WS_WOO + (size_t)li * D * D * 2);
            pg8::Strided<pg8::MapStd> S{{(const char*)CATP(ws), Wo, 256l * D * 2, 256l * D * 2, TX / 256, D / 256}, F.G, bx};
            pg8::gemm_phase(F.lds, pg8::Geo{D, D * 2, D * 2}, S, pg8::EpiResidN{l == 0 ? KIN(I_X) : XP(ws), XP(ws), MODP(ws, l) + 2 * D, GMP(ws, l, 1), HP(ws), STP(ws, l, 1), l != 0, 1});
        }
        if (ctx_out) {
            unsigned char* ws = WSL();
            const char* Wo = even ? (const char*)(ws + WS_WOE + (size_t)li * D * D * 2) : (const char*)(ws + WS_WOO + (size_t)li * D * D * 2);
            pg8::Strided<pg8::MapSplitK> S{{(const char*)CATP(ws), Wo, 256l * D * 2, 256l * D * 2, (D / 8) * 2l, (D / 8) * 2l}, F.G, bx};
            pg8::gemm_phase(F.lds, pg8::Geo{D / 8, D * 2, D * 2}, S, pg8::EpiPartF32{(float*)(ws + WS_PARTK)});
        }
        GRID_BAR();
        if (ctx_out) {
            unsigned char* ws = WSL(); const float* Xb = l == 0 ? KIN(I_CTX) : XP(ws) + (size_t)TX * D;
            prep_rows(F, nullptr, Xb, TX, T, GMP(ws, l, 1), HP(ws), STP(ws, l, 1), (const float*)(ws + WS_PARTK), MODP(ws, l) + 4 * MODW + 2 * D, XP(ws));
            GRID_BAR();
        }
        {
            unsigned char* ws = WSL();
            pg8::Strided<pg8::MapStd> S{{(const char*)HP(ws), (const char*)(ws + WS_W1 + (size_t)l * DFF * D * 2), 256l * D * 2, 256l * D * 2, nMout, DFF / 256}, F.G, bx};
            pg8::gemm_phase(F.lds, pg8::Geo{D, D * 2, D * 2}, S, pg8::EpiAct{(bf16*)(ws + WS_ACT), STP(ws, l, 1), (const float*)(ws + WS_BIASA) + (size_t)l * NMOD * DFF});
        }
        GRID_BAR();
        {
            unsigned char* ws = WSL();
            pg8::Strided<pg8::MapStd> S{{(const char*)(ws + WS_ACT), (const char*)(ws + WS_W2 + (size_t)l * D * DFF * 2), 256l * DFF * 2, 256l * DFF * 2, TX / 256, D / 256}, F.G, bx};
            pg8::gemm_phase(F.lds, pg8::Geo{DFF, 64, DFF * 2, 256 * 128, 128, 256 * 64}, S, pg8::EpiResidN{XP(ws), l + 1 < DEPTH ? XP(ws) : KOUT(), MODP(ws, l) + 5 * D, GMP(ws, l + 1, 0), HP(ws), l + 1 < DEPTH ? STP(ws, l + 1, 0) : nullptr, 1, l + 1 < DEPTH});
        }
        if (ctx_out) {
            unsigned char* ws = WSL();
            pg8::Strided<pg8::MapSplitK> S{{(const char*)(ws + WS_ACT), (const char*)(ws + WS_W2 + (size_t)l * D * DFF * 2), 256l * DFF * 2, 256l * DFF * 2, (DFF / 8 / 64) * 256l * 128, (DFF / 8) * 2l}, F.G, bx};
            pg8::gemm_phase(F.lds, pg8::Geo{DFF / 8, 64, DFF * 2, 256 * 128, 128, 256 * 64}, S, pg8::EpiPartF32{(float*)(ws + WS_PARTK)});
        }
        GRID_BAR();
        if (ctx_out) {
            unsigned char* ws = WSL();
            prep_rows(F, nullptr, XP(ws) + (size_t)TX * D, TX, T, GMP(ws, l + 1, 0), HP(ws), STP(ws, l + 1, 0), (const float*)(ws + WS_PARTK), MODP(ws, l) + 4 * MODW + 5 * D, XP(ws));
            GRID_BAR();
        }
    }
    final_norm_rows(F, KOUT(), KIN(I_FNORM), KOUT());
}

extern "C" void kernel_launch(void* const* d_in, const int* in_sizes, int n_in, void* d_out, int out_size, void* d_ws, size_t ws_size, hipStream_t stream) {
    static int grid = 0;
    if (grid == 0) {
        if (n_in != 20 || in_sizes[0] != TX * D || out_size != TX * D || ws_size < WS_END) { fprintf(stderr, "kernel_launch: shape mismatch: n_in %d in0 %d out %d ws %zu (need %zu)\n", n_in, n_in > 0 ? in_sizes[0] : -1, out_size, ws_size, (size_t)WS_END); grid = -1; return; }
        int dev = 0, cus = 0, per_cu = 0;
        if (hipGetDevice(&dev) != hipSuccess || hipDeviceGetAttribute(&cus, hipDeviceAttributeMultiprocessorCount, dev) != hipSuccess) { fprintf(stderr, "kernel_launch: device query failed\n"); grid = -1; return; }
        if (hipFuncSetAttribute((const void*)fwd, hipFuncAttributeMaxDynamicSharedMemorySize, LDS_BYTES) != hipSuccess) { fprintf(stderr, "kernel_launch: hipFuncSetAttribute failed\n"); grid = -1; return; }
        if (hipOccupancyMaxActiveBlocksPerMultiprocessor(&per_cu, (const void*)fwd, 512, LDS_BYTES) != hipSuccess || per_cu < 1) fprintf(stderr, "kernel_launch: note: occupancy query reports %d workgroups per CU\n", per_cu);
        (void)hipGetLastError();
        grid = cus;
    }
    if (grid < 0) return;
    if (hipMemsetAsync((char*)d_ws + WS_CTL, 0, CTL_ZERO_BYTES, stream) != hipSuccess || hipMemsetAsync((char*)d_ws + WS_STATS, 0, STATS_ZERO_BYTES, stream) != hipSuccess) { fprintf(stderr, "kernel_launch: memset failed\n"); return; }
    Args a{};
    for (int i = 0; i < 20; ++i) a.in[i] = (const float*)d_in[i];
    a.out = (float*)d_out; a.ws = (unsigned char*)d_ws;
    hipLaunchKernelGGL(fwd, dim3(grid), dim3(512), LDS_BYTES, stream, a);
    const hipError_t le = hipPeekAtLastError();
    if (le != hipSuccess) fprintf(stderr, "kernel_launch: launch failed: %s\n", hipGetErrorName(le));
}
```

```cpp
#include <hip/hip_runtime.h>
#include <cstdio>
#include <cstdint>

#define LAS __attribute__((address_space(3)))
#define GAS __attribute__((address_space(1)))
typedef unsigned short bf16;
typedef short bf16x8 __attribute__((ext_vector_type(8)));
typedef short s16x4 __attribute__((ext_vector_type(4)));
typedef float f32x2 __attribute__((ext_vector_type(2)));
typedef float f32x4 __attribute__((ext_vector_type(4)));
typedef float f32x16 __attribute__((ext_vector_type(16)));
typedef unsigned u32x2 __attribute__((ext_vector_type(2)));
typedef unsigned u32x4 __attribute__((ext_vector_type(4)));

constexpr int D = 2048, NB = 4, SEQ = 8192, CTXL = 256, DEPTH = 4;
constexpr int TX = NB * SEQ, TC = NB * CTXL, T = TX + TC;
constexpr int NH = 8, QR = 512, KVR = 256, DN = 128, DR = 64, DV = 128, DQK = DN + DR;
constexpr int MLA_IN = QR + KVR + DR, PW = 1024, INW = MLA_IN + PW, INWP = 2048;
constexpr int DFF = 8192, NKEY = SEQ + CTXL, MODW = 6 * D, NMOD = 5;
constexpr float EPS = 1e-6f;
constexpr float ATTN_SCALE = 0.07216878364870322f;

__device__ __forceinline__ unsigned cvt_pk_bf16(float lo, float hi) { unsigned r; asm volatile("v_cvt_pk_bf16_f32 %0, %1, %2" : "=v"(r) : "v"(lo), "v"(hi)); return r; }
__device__ __forceinline__ float bf2f(unsigned short h) { return __builtin_bit_cast(float, (unsigned)h << 16); }
__device__ __forceinline__ float bflo(unsigned w) { return __builtin_bit_cast(float, w << 16); }
__device__ __forceinline__ float bfhi(unsigned w) { return __builtin_bit_cast(float, w & 0xffff0000u); }

typedef unsigned long long u64;
constexpr float SS_FIX = 16777216.0f;
__device__ __forceinline__ float rs_from(u64 v) { return __builtin_amdgcn_rsqf((float)v * (1.0f / (SS_FIX * 2048.0f)) + 1e-6f); }

namespace pg8 {
constexpr int BM = 256, BK = 64, HALF = 128, HTB = HALF * BK * 2, STAGE_BYTES = 8 * HTB, NXCD = 8, WGM = 8;
__host__ __device__ __forceinline__ int lds_byte(int r, int c) { const int st = (r >> 4) * 2 + (c >> 5), rr = r & 15, cc = c & 31, ob = rr * 64 + cc * 2; return st * 1024 + (ob ^ (((ob >> 9) & 1) << 5)); }
__host__ __device__ __forceinline__ void stage_rc(int b, int& R, int& C) { const int st = b / 1024, sb = b % 1024, swz = sb ^ (((sb >> 9) & 1) << 5); R = (st >> 1) * 16 + swz / 64; C = (st & 1) * 32 + (swz % 64) / 2; }
__host__ __device__ __forceinline__ int perm32(int rho) { const int n = rho >> 4, i = rho & 15; return 8 * (i >> 2) + 4 * n + (i & 3); }

struct Unit { int pm, pn; const char* a; const char* b; };

__host__ __device__ __forceinline__ void tile_swz(int L, int nM, int nN, int& pm, int& pn) {
    const int nwg = nM * nN; int wgid = L;
    { const int q = nwg / NXCD, r = nwg % NXCD, xcd = wgid % NXCD, off = wgid / NXCD; wgid = (xcd < r ? xcd * (q + 1) : r * (q + 1) + (xcd - r) * q) + off; }
    const int nig = WGM * nN, gid = wgid / nig, fm = gid * WGM, gsz = (nM - fm) < WGM ? (nM - fm) : WGM;
    pm = fm + ((wgid % nig) % gsz); pn = (wgid % nig) / gsz;
}
template <class Map> struct Strided {
    Map m; int G, c;
    __device__ __forceinline__ bool next(int i, Unit& u) const { const long L = (long)i * G + c; if (L >= m.total()) return false; m.get((int)L, u); return true; }
};
struct MapStd {
    const char* A; const char* B; long a_tile, b_tile; int nM, nN;
    __device__ __forceinline__ int total() const { return nM * nN; }
    __device__ __forceinline__ void get(int L, Unit& u) const { int pm, pn; tile_swz(L, nM, nN, pm, pn); u.pm = pm; u.pn = pn; u.a = A + (long)pm * a_tile; u.b = B + (long)pn * b_tile; }
};
struct Geo { int K; unsigned lda, ldb; unsigned ksa = BK * 2, ksb = BK * 2; unsigned a32 = 0; };

template <int ACT  > struct EpiStore {
    static constexpr bool PERM = true;
    bf16* O; long ld;
    __device__ __forceinline__ void operator()(const f32x4 (&acc)[2][2][4][2], const Unit& u, int wr, int wc, int fr, int fq) const {
        const long row0 = (long)u.pm * BM + wr * 64 + fr; const int col0 = u.pn * BM + wc * 32 + 8 * fq;
#pragma unroll
        for (int ai = 0; ai < 2; ++ai)
#pragma unroll
            for (int m = 0; m < 4; ++m) { bf16* rowp = O + (row0 + ai * HALF + m * 16) * ld + col0;
#pragma unroll
                for (int bj = 0; bj < 2; ++bj) { f32x4 v0 = acc[ai][bj][m][0], v1 = acc[ai][bj][m][1];
                    if (ACT == 1) {
#pragma unroll
                        for (int e = 0; e < 4; ++e) { const float a = fmaxf(v0[e], 0.f), b = fmaxf(v1[e], 0.f); v0[e] = a * a; v1[e] = b * b; } }
                    u32x4 w; w.x = cvt_pk_bf16(v0[0], v0[1]); w.y = cvt_pk_bf16(v0[2], v0[3]); w.z = cvt_pk_bf16(v1[0], v1[1]); w.w = cvt_pk_bf16(v1[2], v1[3]);
                    *(u32x4*)(rowp + bj * HALF) = w; } }
    }
};
struct EpiNormStore {
    static constexpr bool PERM = true;
    bf16* O; long ld; const u64* st; const float* bias; int ldb;
    __device__ __forceinline__ void operator()(const f32x4 (&acc)[2][2][4][2], const Unit& u, int wr, int wc, int fr, int fq) const {
        const long row0 = (long)u.pm * BM + wr * 64 + fr; const int col0 = u.pn * BM + wc * 32 + 8 * fq; const int j = u.pm < 128 ? (u.pm >> 5) : 4;
        f32x4 bv[2][2];
#pragma unroll
        for (int bj = 0; bj < 2; ++bj)
#pragma unroll
            for (int n = 0; n < 2; ++n) bv[bj][n] = *(const f32x4*)(bias + (long)j * ldb + col0 + bj * HALF + 4 * n);
        float rsa[8]; u64 sva[8];
#pragma unroll
        for (int rg = 0; rg < 8; ++rg) sva[rg] = st[row0 + (rg >> 2) * HALF + (rg & 3) * 16];
        __builtin_amdgcn_sched_barrier(0);
#pragma unroll
        for (int rg = 0; rg < 8; ++rg) rsa[rg] = rs_from(sva[rg]);
#pragma unroll
        for (int ai = 0; ai < 2; ++ai)
#pragma unroll
            for (int m = 0; m < 4; ++m) { const long row = row0 + ai * HALF + m * 16; const float rs = rsa[ai * 4 + m]; bf16* rowp = O + row * ld + col0;
#pragma unroll
                for (int bj = 0; bj < 2; ++bj) { const f32x4 v0 = acc[ai][bj][m][0] * rs + bv[bj][0], v1 = acc[ai][bj][m][1] * rs + bv[bj][1];
                    u32x4 w; w.x = cvt_pk_bf16(v0[0], v0[1]); w.y = cvt_pk_bf16(v0[2], v0[3]); w.z = cvt_pk_bf16(v1[0], v1[1]); w.w = cvt_pk_bf16(v1[2], v1[3]);
                    *(u32x4*)(rowp + bj * HALF) = w; } }
    }
};
struct EpiAct {
    static constexpr bool PERM = true;
    bf16* O; const u64* st; const float* bias;
    __device__ __forceinline__ void operator()(const f32x4 (&acc)[2][2][4][2], const Unit& u, int wr, int wc, int fr, int fq) const {
        bf16* base = O + (((long)u.pm * (DFF / 32) + u.pn * 8 + wc) * 256 + wr * 64 + fr) * 32 + 8 * fq;
        const int j = u.pm < 128 ? (u.pm >> 5) : 4; const int col0 = u.pn * BM + wc * 32 + 8 * fq; const long row0 = (long)u.pm * BM + wr * 64 + fr;
        f32x4 bv[2][2];
#pragma unroll
        for (int bj = 0; bj < 2; ++bj)
#pragma unroll
            for (int n = 0; n < 2; ++n) bv[bj][n] = *(const f32x4*)(bias + (long)j * DFF + col0 + bj * HALF + 4 * n);
        float rsa[8]; u64 sva[8];
#pragma unroll
        for (int rg = 0; rg < 8; ++rg) sva[rg] = st[row0 + (rg >> 2) * HALF + (rg & 3) * 16];
        __builtin_amdgcn_sched_barrier(0);
#pragma unroll
        for (int rg = 0; rg < 8; ++rg) rsa[rg] = rs_from(sva[rg]);
#pragma unroll
        for (int ai = 0; ai < 2; ++ai)
#pragma unroll
            for (int m = 0; m < 4; ++m) { const float rs = rsa[ai * 4 + m];
#pragma unroll
                for (int bj = 0; bj < 2; ++bj) { f32x4 v0 = acc[ai][bj][m][0] * rs + bv[bj][0], v1 = acc[ai][bj][m][1] * rs + bv[bj][1];
#pragma unroll
                    for (int e = 0; e < 4; ++e) { const float a = fmaxf(v0[e], 0.f), b = fmaxf(v1[e], 0.f); v0[e] = a * a; v1[e] = b * b; }
                    u32x4 w; w.x = cvt_pk_bf16(v0[0], v0[1]); w.y = cvt_pk_bf16(v0[2], v0[3]); w.z = cvt_pk_bf16(v1[0], v1[1]); w.w = cvt_pk_bf16(v1[2], v1[3]);
                    __builtin_nontemporal_store(w, (u32x4*)(base + ((long)bj * 4 * 256 + ai * HALF + m * 16) * 32)); } }
    }
};
struct EpiKV {
    static constexpr bool PERM = true;
    bf16* KB; bf16* VB;
    __device__ __forceinline__ void operator()(const f32x4 (&acc)[2][2][4][2], const Unit& u, int wr, int wc, int fr, int fq) const {
        const int b = u.pm < 128 ? (u.pm >> 5) : (u.pm - 128); const int key0 = u.pm < 128 ? 256 + (u.pm & 31) * 256 : 0;
        const long kr0 = (long)b * NKEY + key0 + wr * 64 + fr; const int c0 = wc * 32 + 8 * fq;
#pragma unroll
        for (int ai = 0; ai < 2; ++ai)
#pragma unroll
            for (int m = 0; m < 4; ++m) { const long kr = kr0 + ai * HALF + m * 16;
#pragma unroll
                for (int bj = 0; bj < 2; ++bj) { const f32x4 v0 = acc[ai][bj][m][0], v1 = acc[ai][bj][m][1];
                    u32x4 w; w.x = cvt_pk_bf16(v0[0], v0[1]); w.y = cvt_pk_bf16(v0[2], v0[3]); w.z = cvt_pk_bf16(v1[0], v1[1]); w.w = cvt_pk_bf16(v1[2], v1[3]);
                    bf16* p = bj == 0 ? KB + kr * (NH * DQK) + u.pn * DQK + c0 : VB + kr * (NH * DV) + u.pn * DV + c0;
                    *(u32x4*)p = w; } }
    }
};
struct EpiPool {
    static constexpr bool PERM = true;
    bf16* CAT; const float* pscale;
    __device__ __forceinline__ void operator()(const f32x4 (&acc)[2][2][4][2], const Unit& u, int wr, int wc, int fr, int fq) const {
        const long row0 = (long)u.pm * BM + wr * 64 + fr; const int col0 = u.pn * BM + wc * 32 + 8 * fq;
        f32x4 sv[2][2];
#pragma unroll
        for (int bj = 0; bj < 2; ++bj)
#pragma unroll
            for (int n = 0; n < 2; ++n) sv[bj][n] = *(const f32x4*)(pscale + col0 + bj * HALF + 4 * n);
#pragma unroll
        for (int ai = 0; ai < 2; ++ai)
#pragma unroll
            for (int m = 0; m < 4; ++m) { bf16* rowp = CAT + (row0 + ai * HALF + m * 16) * D + PW + col0;
#pragma unroll
                for (int bj = 0; bj < 2; ++bj) { const f32x4 v0 = acc[ai][bj][m][0] * sv[bj][0], v1 = acc[ai][bj][m][1] * sv[bj][1];
                    u32x4 w; w.x = cvt_pk_bf16(v0[0], v0[1]); w.y = cvt_pk_bf16(v0[2], v0[3]); w.z = cvt_pk_bf16(v1[0], v1[1]); w.w = cvt_pk_bf16(v1[2], v1[3]);
                    *(u32x4*)(rowp + bj * HALF) = w; } }
    }
};
struct EpiQ {
    static constexpr bool PERM = false;
    bf16* Q; const f32x2* rope;
    __device__ __forceinline__ void operator()(const f32x4 (&acc)[2][2][4][2], const Unit& u, int wr, int wc, int fr, int fq) const {
        const bool isx = u.pm < 128; const f32x2* __restrict__ rope = this->rope; bf16* __restrict__ Q = this->Q;
#pragma unroll
        for (int ai = 0; ai < 2; ++ai)
#pragma unroll
            for (int m = 0; m < 4; ++m) { const int row = u.pm * BM + ai * HALF + wr * 64 + m * 16 + fr; const int t = row & (SEQ - 1); const int pos0 = t >> 6, pos1 = t & 63;
#pragma unroll
                for (int bj = 0; bj < 2; ++bj) { const int cb = u.pn * BM + bj * HALF + wc * 32; const int dd = cb % DQK;
                    f32x4 v0 = acc[ai][bj][m][0], v1 = acc[ai][bj][m][1];
                    if (dd >= DN && isx) { const int pos = ((dd - DN) >> 5) ? pos1 : pos0; const f32x4* rp = (const f32x4*)(rope + pos * 16 + 4 * fq);
                        const f32x4 r0 = rp[0], r1 = rp[1];
                        const float c[4] = {r0[0], r0[2], r1[0], r1[2]}, s[4] = {r0[1], r0[3], r1[1], r1[3]};
#pragma unroll
                        for (int e = 0; e < 4; ++e) { const float x0 = v0[e], x1 = v1[e]; v0[e] = x0 * c[e] - x1 * s[e]; v1[e] = x1 * c[e] + x0 * s[e]; } }
                    bf16* p = Q + (long)row * (NH * DQK) + cb + 4 * fq;
                    u32x2 w0, w1; w0.x = cvt_pk_bf16(v0[0], v0[1]); w0.y = cvt_pk_bf16(v0[2], v0[3]); w1.x = cvt_pk_bf16(v1[0], v1[1]); w1.y = cvt_pk_bf16(v1[2], v1[3]);
                    *(u32x2*)p = w0; *(u32x2*)(p + 16) = w1; } }
    }
};
struct EpiResid {
    static constexpr bool PERM = false;
    const float* Xin; float* Xout; const float* gate;
    __device__ __forceinline__ void operator()(const f32x4 (&acc)[2][2][4][2], const Unit& u, int wr, int wc, int fr, int fq) const {
        const int j = u.pm < 128 ? (u.pm >> 5) : 4; const float* gp = gate + (long)j * MODW; const int col0 = u.pn * BM + wc * 32 + 4 * fq;
        f32x4 gv[2][2];
#pragma unroll
        for (int bj = 0; bj < 2; ++bj)
#pragma unroll
            for (int n = 0; n < 2; ++n) gv[bj][n] = *(const f32x4*)(gp + col0 + bj * HALF + n * 16);
#pragma unroll
        for (int ai = 0; ai < 2; ++ai)
#pragma unroll
            for (int m = 0; m < 4; ++m) { const long off = ((long)u.pm * BM + ai * HALF + wr * 64 + m * 16 + fr) * D + col0;
#pragma unroll
                for (int bj = 0; bj < 2; ++bj)
#pragma unroll
                    for (int n = 0; n < 2; ++n) { const f32x4 xs = *(const f32x4*)(Xin + off + bj * HALF + n * 16); *(f32x4*)(Xout + off + bj * HALF + n * 16) = xs + gv[bj][n] * acc[ai][bj][m][n]; }
                if (m & 1) asm volatile("" ::: "memory"); }
    }
};

struct EpiResidN {
    static constexpr bool PERM = true;
    const float* Xin; float* Xout; const float* gate; const float* gm; bf16* XG; u64* st;
    int in_tiled, out_tiled;
    __device__ __forceinline__ void operator()(const f32x4 (&acc)[2][2][4][2], const Unit& u, int wr, int wc, int fr, int fq) const {
        const int j = u.pm < 128 ? (u.pm >> 5) : 4; const float* gp = gate + (long)j * MODW; const float* mp = gm + (long)j * D; const int col0 = u.pn * BM + wc * 32 + 8 * fq;
        f32x4 gv[2][2], mv[2][2];
#pragma unroll
        for (int bj = 0; bj < 2; ++bj)
#pragma unroll
            for (int n = 0; n < 2; ++n) { gv[bj][n] = *(const f32x4*)(gp + col0 + bj * HALF + n * 4); mv[bj][n] = st ? *(const f32x4*)(mp + col0 + bj * HALF + n * 4) : (f32x4){0.f, 0.f, 0.f, 0.f}; }
        const long rowb = (long)u.pm * BM + wr * 64 + fr;
        const long tb16 = (((long)(u.pm * 8 + u.pn) * 8 + (wr * 4 + wc)) * 1024 + (fq * 16 + fr)) * 8;
        const bf16* XTi = (const bf16*)Xin; bf16* XTo = (bf16*)Xout;
        f32x4 xr[3][2][2];
#define ER_LOAD(rg, slot) do { if (in_tiled) { _Pragma("unroll") for (int bj = 0; bj < 2; ++bj) { const u32x4 w_ = __builtin_nontemporal_load((const u32x4*)(XTi + tb16 + (rg) * 1024 + bj * 512)); \
                xr[slot][bj][0] = (f32x4){bflo(w_.x), bfhi(w_.x), bflo(w_.y), bfhi(w_.y)}; xr[slot][bj][1] = (f32x4){bflo(w_.z), bfhi(w_.z), bflo(w_.w), bfhi(w_.w)}; } } \
            else { const long off_ = (rowb + ((rg) >> 2) * HALF + ((rg) & 3) * 16) * D + col0; \
                _Pragma("unroll") for (int bj = 0; bj < 2; ++bj) _Pragma("unroll") for (int n = 0; n < 2; ++n) xr[slot][bj][n] = *(const f32x4*)(Xin + off_ + bj * HALF + n * 4); } } while (0)
        ER_LOAD(0, 0); ER_LOAD(1, 1);
#pragma unroll
        for (int rg = 0; rg < 8; ++rg) { const int ai = rg >> 2, m = rg & 3, sl = rg % 3;
            if (rg + 2 < 8) ER_LOAD(rg + 2, (rg + 2) % 3);
            const long row = rowb + ai * HALF + m * 16; const long off = row * D + col0; float ss = 0.f;
#pragma unroll
            for (int bj = 0; bj < 2; ++bj) { f32x4 xs[2];
#pragma unroll
                for (int n = 0; n < 2; ++n) { xs[n] = xr[sl][bj][n] + gv[bj][n] * acc[ai][bj][m][n]; ss += (xs[n][0] * xs[n][0] + xs[n][1] * xs[n][1]) + (xs[n][2] * xs[n][2] + xs[n][3] * xs[n][3]); }
                if (out_tiled) { u32x4 w; w.x = cvt_pk_bf16(xs[0][0], xs[0][1]); w.y = cvt_pk_bf16(xs[0][2], xs[0][3]); w.z = cvt_pk_bf16(xs[1][0], xs[1][1]); w.w = cvt_pk_bf16(xs[1][2], xs[1][3]);
                    __builtin_nontemporal_store(w, (u32x4*)(XTo + tb16 + rg * 1024 + bj * 512)); }
                else { *(f32x4*)(Xout + off + bj * HALF) = xs[0]; *(f32x4*)(Xout + off + bj * HALF + 4) = xs[1]; }
                if (st) { const f32x4 h0 = xs[0] * mv[bj][0], h1 = xs[1] * mv[bj][1]; u32x4 w; w.x = cvt_pk_bf16(h0[0], h0[1]); w.y = cvt_pk_bf16(h0[2], h0[3]); w.z = cvt_pk_bf16(h1[0], h1[1]); w.w = cvt_pk_bf16(h1[2], h1[3]);
                    *(u32x4*)(XG + off + bj * HALF) = w; } }
            if (st) { ss += __shfl_xor(ss, 16); ss += __shfl_xor(ss, 32);
                if (fq == 0) __hip_atomic_fetch_add(st + row, (u64)(ss * SS_FIX), __ATOMIC_RELAXED, __HIP_MEMORY_SCOPE_AGENT); }
        }
#undef ER_LOAD
    }
};
struct EpiPartF32 {
    static constexpr bool PERM = false;
    float* O;
    __device__ __forceinline__ void operator()(const f32x4 (&acc)[2][2][4][2], const Unit& u, int wr, int wc, int fr, int fq) const {
        const int col0 = u.pn * BM + wc * 32 + 4 * fq;
#pragma unroll
        for (int ai = 0; ai < 2; ++ai)
#pragma unroll
            for (int m = 0; m < 4; ++m) { float* rowp = O + ((long)u.pm * BM + ai * HALF + wr * 64 + m * 16 + fr) * D + col0;
#pragma unroll
                for (int bj = 0; bj < 2; ++bj)
#pragma unroll
                    for (int n = 0; n < 2; ++n) *(f32x4*)(rowp + bj * HALF + n * 16) = acc[ai][bj][m][n]; }
    }
};
struct MapSplitK {
    const char* A; const char* B; long a_tile, b_tile; long ka, kb;
    __device__ __forceinline__ int total() const { return 256; }
    __device__ __forceinline__ void get(int L, Unit& u) const { const int sp = L >> 5, pmc = (L >> 3) & 3, pn = L & 7;
        u.a = A + (long)(128 + pmc) * a_tile + sp * ka; u.b = B + (long)pn * b_tile + sp * kb; u.pm = sp * 4 + pmc; u.pn = pn; }
};

struct EpiYt {
    static constexpr bool PERM = true;
    bf16* Yt; const u64* st; const float* bias;
    __device__ __forceinline__ void operator()(const f32x4 (&acc)[2][2][4][2], const Unit& u, int wr, int wc, int fr, int fq) const {
        const int pmr = u.pm & 3, g = (u.pm >> 2) & 3, b = u.pm >> 4, ri = pmr >> 1; const int mr0 = (pmr & 1) * 256 + wr * 64 + fr; const int m0 = g * 512 + mr0;
        const float* bp = bias + (b * 4 + g) * 1024 + ri * 512 + mr0;
        float rsv[2][8]; u64 svv[2][8];
#pragma unroll
        for (int bj = 0; bj < 2; ++bj)
#pragma unroll
            for (int e = 0; e < 8; ++e) svv[bj][e] = st[(long)b * SEQ + (8 * fq + e) * 256 + u.pn * 8 + bj * 4 + wc];
        __builtin_amdgcn_sched_barrier(0);
#pragma unroll
        for (int bj = 0; bj < 2; ++bj)
#pragma unroll
            for (int e = 0; e < 8; ++e) rsv[bj][e] = rs_from(svv[bj][e]);
        float bsa[8];
#pragma unroll
        for (int rg = 0; rg < 8; ++rg) bsa[rg] = bp[(rg >> 2) * HALF + (rg & 3) * 16];
#pragma unroll
        for (int ai = 0; ai < 2; ++ai)
#pragma unroll
            for (int m = 0; m < 4; ++m) { const long mp = (long)b * D + m0 + ai * HALF + m * 16; const float bs = bsa[ai * 4 + m];
#pragma unroll
                for (int bj = 0; bj < 2; ++bj) { const f32x4 a0 = acc[ai][bj][m][0], a1 = acc[ai][bj][m][1]; const int j2 = u.pn * 8 + bj * 4 + wc;
                    u32x4 w; w.x = cvt_pk_bf16(a0[0] * rsv[bj][0] + bs, a0[1] * rsv[bj][1] + bs); w.y = cvt_pk_bf16(a0[2] * rsv[bj][2] + bs, a0[3] * rsv[bj][3] + bs);
                    w.z = cvt_pk_bf16(a1[0] * rsv[bj][4] + bs, a1[1] * rsv[bj][5] + bs); w.w = cvt_pk_bf16(a1[2] * rsv[bj][6] + bs, a1[3] * rsv[bj][7] + bs);
                    *(u32x4*)(Yt + ((mp * 256 + j2) * 64 + ri * 32 + 8 * fq)) = w; } }
    }
};
struct EpiYtc {
    static constexpr bool PERM = true;
    bf16* O; const u64* st; const float* bias;
    __device__ __forceinline__ void operator()(const f32x4 (&acc)[2][2][4][2], const Unit& u, int wr, int wc, int fr, int fq) const {
        const int b = u.pm >> 3, g = (u.pm >> 1) & 3, ri = u.pn; const int mr0 = (u.pm & 1) * 256 + wr * 64 + fr;
        const float* bp = bias + (16 + g) * 1024 + ri * 512 + mr0;
        float rsv[2][8];
#pragma unroll
        for (int bj = 0; bj < 2; ++bj)
#pragma unroll
            for (int e = 0; e < 8; ++e) rsv[bj][e] = rs_from(st[(long)TX + b * CTXL + bj * HALF + wc * 32 + 8 * fq + e]);
        float bsa[8];
#pragma unroll
        for (int rg = 0; rg < 8; ++rg) bsa[rg] = bp[(rg >> 2) * HALF + (rg & 3) * 16];
#pragma unroll
        for (int ai = 0; ai < 2; ++ai)
#pragma unroll
            for (int m = 0; m < 4; ++m) { bf16* rowp = O + ((long)u.pm * BM + ai * HALF + wr * 64 + m * 16 + fr) * (2 * CTXL) + ri * CTXL + wc * 32 + 8 * fq; const float bs = bsa[ai * 4 + m];
#pragma unroll
                for (int bj = 0; bj < 2; ++bj) { const f32x4 a0 = acc[ai][bj][m][0], a1 = acc[ai][bj][m][1];
                    u32x4 w; w.x = cvt_pk_bf16(a0[0] * rsv[bj][0] + bs, a0[1] * rsv[bj][1] + bs); w.y = cvt_pk_bf16(a0[2] * rsv[bj][2] + bs, a0[3] * rsv[bj][3] + bs);
                    w.z = cvt_pk_bf16(a1[0] * rsv[bj][4] + bs, a1[1] * rsv[bj][5] + bs); w.w = cvt_pk_bf16(a1[2] * rsv[bj][6] + bs, a1[3] * rsv[bj][7] + bs);
                    *(u32x4*)(rowp + bj * HALF) = w; } }
    }
};
struct EpiF2 {
    static constexpr bool PERM = true;
    bf16* G;
    __device__ __forceinline__ void operator()(const f32x4 (&acc)[2][2][4][2], const Unit& u, int wr, int wc, int fr, int fq) const {
        asm volatile("" : "+v"(fr));
#pragma unroll
        for (int ai = 0; ai < 2; ++ai)
#pragma unroll
            for (int m = 0; m < 4; ++m) { const int R = u.pm * BM + ai * HALF + wr * 64 + m * 16 + fr; const int j2q = R & 63, mp = (R >> 6) & (D - 1), b = R >> 17;
#pragma unroll
                for (int bj = 0; bj < 2; ++bj) { const int k1 = bj * 16 + wc * 4 + fq; float c[4], sn[4];
#pragma unroll
                    for (int e = 0; e < 4; ++e) { const float rev = (float)((4 * j2q + e) * k1) * (1.0f / 8192.0f); c[e] = __builtin_amdgcn_cosf(rev); sn[e] = __builtin_amdgcn_sinf(rev); }
                    const f32x4 gr = acc[ai][bj][m][0], gi = acc[ai][bj][m][1]; float orr[4], oi[4];
#pragma unroll
                    for (int e = 0; e < 4; ++e) { orr[e] = c[e] * gr[e] + sn[e] * gi[e]; oi[e] = c[e] * gi[e] - sn[e] * gr[e]; }
                    bf16* p = G + ((((long)b * 32 + k1) * D + mp) * 512 + 4 * j2q);
                    u32x2 w0, w1; w0.x = cvt_pk_bf16(orr[0], orr[1]); w0.y = cvt_pk_bf16(orr[2], orr[3]); w1.x = cvt_pk_bf16(oi[0], oi[1]); w1.y = cvt_pk_bf16(oi[2], oi[3]);
                    *(u32x2*)p = w0; *(u32x2*)(p + 256) = w1; __builtin_amdgcn_sched_barrier(0); } }
    }
};
struct EpiF3 {
    static constexpr bool PERM = true;
    bf16* O;
    __device__ __forceinline__ void operator()(const f32x4 (&acc)[2][2][4][2], const Unit& u, int wr, int wc, int fr, int fq) const {
        const long row0 = (long)(u.pm >> 5) * SEQ + (u.pm & 31); const int col0 = u.pn * BM + wc * 32 + 8 * fq;
#pragma unroll
        for (int ai = 0; ai < 2; ++ai)
#pragma unroll
            for (int m = 0; m < 4; ++m) { bf16* rowp = O + (row0 + 32 * (ai * HALF + wr * 64 + m * 16 + fr)) * D + col0;
#pragma unroll
                for (int bj = 0; bj < 2; ++bj) { const f32x4 v0 = acc[ai][bj][m][0], v1 = acc[ai][bj][m][1];
                    u32x4 w; w.x = cvt_pk_bf16(v0[0], v0[1]); w.y = cvt_pk_bf16(v0[2], v0[3]); w.z = cvt_pk_bf16(v1[0], v1[1]); w.w = cvt_pk_bf16(v1[2], v1[3]);
                    *(u32x4*)(rowp + bj * HALF) = w; } }
    }
};

template <class Epi, class Sched, bool ALIGN_EPI = true, bool BGATHER = false>
__device__ __forceinline__ void gemm_phase(LAS unsigned char* lds, const Geo g, const Sched& S, const Epi& E) {
    int tid = threadIdx.x; asm volatile("" : "+v"(tid));
    const int wid = __builtin_amdgcn_readfirstlane(tid >> 6), lane = tid & 63, wr = wid >> 2, wc = wid & 3, fr = lane & 15, fq = lane >> 4;
    int K = g.K; asm volatile("" : "+s"(K));
    const int nt = K / BK;
    unsigned voffA[2], voffB[2];
#pragma unroll
    for (int i = 0; i < 2; ++i) { int R, C; stage_rc(tid * 16 + i * 8192, R, C); const int Rb = Epi::PERM ? ((R & ~31) + perm32(R & 31)) : R;
        voffA[i] = (unsigned)R * g.lda + (g.a32 ? (unsigned)(C & 31) * 2u + (unsigned)(C >> 5) * g.a32 : (unsigned)C * 2u); voffB[i] = (BGATHER ? (unsigned)((Rb & 31) * 256 + (Rb >> 5)) : (unsigned)Rb) * g.ldb + (unsigned)C * 2u; }
    const size_t kstepA = g.ksa, kstepB = g.ksb;
    const size_t hstepA = (size_t)HALF * g.lda, hstepB = (size_t)(BGATHER ? 4 : HALF) * g.ldb;
    const unsigned ldsw = (unsigned)wid * 1024u;
    const int aoff = lds_byte(wr * 64 + fr, fq * 8), boff = lds_byte(wc * 32 + fr, fq * 8);
#define PG8_SA(b, h) (((b) * 2 + (h)) * HTB)
#define PG8_SB(b, h) ((4 + (b) * 2 + (h)) * HTB)
#define PG8_STAGE(bufoff, gbase, voff) do { _Pragma("unroll") for (int _i = 0; _i < 2; ++_i) \
        __builtin_amdgcn_global_load_lds((const unsigned*)((const char*)(gbase) + (voff)[_i]), (LAS unsigned*)(lds + (bufoff) + ldsw + _i * 8192), 16, 0, 0); } while (0)
#define PG8_LDA(dst, b, h) do { _Pragma("unroll") for (int m = 0; m < 4; ++m) _Pragma("unroll") for (int k = 0; k < 2; ++k) dst[m][k] = *(const LAS bf16x8*)(lds + PG8_SA(b, h) + aoff + m * 2048 + k * 1024); } while (0)
#define PG8_LDB(dst, b, h) do { _Pragma("unroll") for (int n = 0; n < 2; ++n) _Pragma("unroll") for (int k = 0; k < 2; ++k) dst[n][k] = *(const LAS bf16x8*)(lds + PG8_SB(b, h) + boff + n * 2048 + k * 1024); } while (0)
#define PG8_MMA(ai, bj, At, Bt) do { __builtin_amdgcn_s_setprio(1); _Pragma("unroll") for (int m = 0; m < 4; ++m) _Pragma("unroll") for (int n = 0; n < 2; ++n) _Pragma("unroll") for (int k = 0; k < 2; ++k) \
        acc[ai][bj][m][n] = __builtin_amdgcn_mfma_f32_16x16x32_bf16(Bt[n][k], At[m][k], acc[ai][bj][m][n], 0, 0, 0); __builtin_amdgcn_s_setprio(0); } while (0)
#define PG8_WAIT_V(n) asm volatile("s_waitcnt vmcnt(" #n ")" ::: "memory")
#define PG8_WAIT_L(n) asm volatile("s_waitcnt lgkmcnt(" #n ")" ::: "memory")
#define PG8_BAR __builtin_amdgcn_s_barrier()
#define PG8_SCHED __builtin_amdgcn_sched_barrier(0)
    Unit cur, nxt; int ui = 0;
    if (!S.next(0, cur)) return;
    f32x4 acc[2][2][4][2];
#pragma unroll
    for (int a = 0; a < 2; ++a)
#pragma unroll
        for (int b = 0; b < 2; ++b)
#pragma unroll
            for (int m = 0; m < 4; ++m)
#pragma unroll
                for (int n = 0; n < 2; ++n) acc[a][b][m][n] = (f32x4){0.f, 0.f, 0.f, 0.f};
    bf16x8 At[4][2], B0[2][2], B1[2][2];
    const char* cA = cur.a; const char* cB = cur.b;
    PG8_STAGE(PG8_SB(0, 0), cB, voffB); PG8_STAGE(PG8_SB(0, 1), cB + hstepB, voffB); PG8_STAGE(PG8_SA(0, 0), cA, voffA); PG8_STAGE(PG8_SA(0, 1), cA + hstepA, voffA);
    if (wr == 1) PG8_BAR;
    PG8_WAIT_V(2); PG8_BAR;
    PG8_STAGE(PG8_SB(1, 0), cB + kstepB, voffB); PG8_STAGE(PG8_SA(1, 0), cA + kstepA, voffA); PG8_STAGE(PG8_SB(1, 1), cB + hstepB + kstepB, voffB);
    PG8_WAIT_V(6); PG8_BAR;
    for (;;) {
        const bool has_next = S.next(ui + 1, nxt);
        const char* nA = has_next ? nxt.a : cA; const char* nB = has_next ? nxt.b : cB;
        for (int t = 0; t < nt; t += 2) {
            const bool last = (t == nt - 2);
            const char* a1 = cA + (size_t)(t + 1) * kstepA;
            const char* a2 = last ? nA : cA + (size_t)(t + 2) * kstepA; const char* b2 = last ? nB : cB + (size_t)(t + 2) * kstepB;
            const char* a3 = a2 + kstepA; const char* b3 = b2 + kstepB;
            PG8_LDB(B0, 0, 0); PG8_LDB(B1, 0, 1); PG8_SCHED; PG8_LDA(At, 0, 0); PG8_STAGE(PG8_SA(1, 1), a1 + hstepA, voffA);
            PG8_WAIT_V(8); PG8_WAIT_L(0); PG8_BAR; PG8_MMA(0, 0, At, B0); PG8_MMA(0, 1, At, B1); PG8_BAR; PG8_SCHED;
            PG8_LDA(At, 0, 1); PG8_STAGE(PG8_SB(0, 0), b2, voffB); PG8_STAGE(PG8_SB(0, 1), b2 + hstepB, voffB); PG8_STAGE(PG8_SA(0, 0), a2, voffA);
            PG8_WAIT_V(8); PG8_WAIT_L(0); PG8_BAR; PG8_MMA(1, 0, At, B0); PG8_MMA(1, 1, At, B1); PG8_BAR; PG8_SCHED;
            PG8_LDB(B0, 1, 0); PG8_LDB(B1, 1, 1); PG8_SCHED; PG8_LDA(At, 1, 0); PG8_STAGE(PG8_SA(0, 1), a2 + hstepA, voffA);
            PG8_WAIT_V(8); PG8_WAIT_L(0); PG8_BAR; PG8_MMA(0, 0, At, B0); PG8_MMA(0, 1, At, B1); PG8_BAR; PG8_SCHED;
            PG8_LDA(At, 1, 1); PG8_STAGE(PG8_SB(1, 0), b3, voffB); PG8_STAGE(PG8_SB(1, 1), b3 + hstepB, voffB); PG8_STAGE(PG8_SA(1, 0), a3, voffA);
            PG8_WAIT_V(8); PG8_WAIT_L(0); PG8_BAR; PG8_MMA(1, 0, At, B0); PG8_MMA(1, 1, At, B1); PG8_BAR; PG8_SCHED;
        }
        if constexpr (ALIGN_EPI) { if (wr == 0) PG8_BAR; }
        E(acc, cur, wr, wc, fr, fq);
        if (!has_next) break;
#pragma unroll
        for (int a = 0; a < 2; ++a)
#pragma unroll
            for (int b = 0; b < 2; ++b)
#pragma unroll
                for (int m = 0; m < 4; ++m)
#pragma unroll
                    for (int n = 0; n < 2; ++n) acc[a][b][m][n] = (f32x4){0.f, 0.f, 0.f, 0.f};
        cur = nxt; cA = nA; cB = nB; ++ui;
        if constexpr (ALIGN_EPI) { if (wr == 1) PG8_BAR; }
    }
    PG8_WAIT_V(0);
    if constexpr (!ALIGN_EPI) { if (wr == 0) PG8_BAR; }
    PG8_BAR;
#undef PG8_SA
#undef PG8_SB
#undef PG8_STAGE
#undef PG8_LDA
#undef PG8_LDB
#undef PG8_MMA
#undef PG8_WAIT_V
#undef PG8_WAIT_L
#undef PG8_BAR
#undef PG8_SCHED
}
}

namespace att {
constexpr int NW = 8, QBLK = 32, KVBLK = 64;
constexpr int LDQ = NH * DQK, LDK = NH * DQK, LDV = NH * DV, LDO = D;
constexpr int SHM_V = KVBLK * DV * 2, SHM_K = KVBLK * DQK * 2, SHM_ATTN = 2 * SHM_V + 2 * SHM_K + NW * 64 * 4;
constexpr float THR = 8.f;
#define SBAR() __builtin_amdgcn_sched_barrier(0)
#define KSWZ(row, colB) ((row) * 384 + ((colB) ^ ((((row) >> 1) & 7) << 4)))
__device__ __forceinline__ int crow(int r, int hi) { return (r & 3) + 8 * (r >> 2) + 4 * hi; }
__device__ __forceinline__ void partialSM(f32x16& p0, f32x16& p1, float& m_reg, float& mn, float& alpha) {
  constexpr float C = ATTN_SCALE * 1.4426950408889634f;
  float pmax = p0[0];
#pragma unroll
  for (int r = 1; r < 16; ++r) pmax = fmaxf(pmax, p0[r]);
#pragma unroll
  for (int r = 0; r < 16; ++r) pmax = fmaxf(pmax, p1[r]);
  { auto rr = __builtin_amdgcn_permlane32_swap(__float_as_uint(pmax), __float_as_uint(pmax), false, false);
    pmax = fmaxf(__uint_as_float(rr[0]), __uint_as_float(rr[1])); }
  if (__builtin_expect(__all(pmax - m_reg <= THR / ATTN_SCALE), 1)) { mn = m_reg; alpha = 1.f; }
  else { mn = fmaxf(m_reg, pmax); alpha = __builtin_amdgcn_exp2f((m_reg - mn) * C); m_reg = mn; }
  const float mnC = -mn * C;
#pragma unroll
  for (int r = 0; r < 16; ++r) p0[r] = fmaf(p0[r], C, mnC);
#pragma unroll
  for (int r = 0; r < 16; ++r) p1[r] = fmaf(p1[r], C, mnC);
#pragma unroll
  for (int r = 0; r < 16; ++r) p0[r] = __builtin_amdgcn_exp2f(p0[r]);
}
__device__ __forceinline__ void finishSM(f32x16& p0, f32x16& p1, float alpha, float& l_reg, bf16x8& pa0, bf16x8& pa1, bf16x8& pa2, bf16x8& pa3) {
#pragma unroll
  for (int r = 0; r < 16; ++r) p1[r] = __builtin_amdgcn_exp2f(p1[r]);
  float ps = 0;
#pragma unroll
  for (int r = 0; r < 16; ++r) ps += p0[r];
#pragma unroll
  for (int r = 0; r < 16; ++r) ps += p1[r];
  { auto rr = __builtin_amdgcn_permlane32_swap(__float_as_uint(ps), __float_as_uint(ps), false, false);
    ps = __uint_as_float(rr[0]) + __uint_as_float(rr[1]); }
  l_reg = l_reg * alpha + ps;
#define PK4(P, BASE, OUT) do { unsigned a0 = cvt_pk_bf16(P[BASE + 0], P[BASE + 1]), a1 = cvt_pk_bf16(P[BASE + 2], P[BASE + 3]);   \
    unsigned b0 = cvt_pk_bf16(P[BASE + 4], P[BASE + 5]), b1 = cvt_pk_bf16(P[BASE + 6], P[BASE + 7]);                              \
    auto r0 = __builtin_amdgcn_permlane32_swap(a0, b0, false, false); auto r1 = __builtin_amdgcn_permlane32_swap(a1, b1, false, false); \
    u32x4 w = {r0[0], r1[0], r0[1], r1[1]}; OUT = __builtin_bit_cast(bf16x8, w); } while (0)
  PK4(p0, 0, pa0); PK4(p0, 8, pa1); PK4(p1, 0, pa2); PK4(p1, 8, pa3);
#undef PK4
}
__device__ __forceinline__ void qkt(f32x16& p0, f32x16& p1, const LAS char* Ks, const bf16x8* qr, int r32, int hi) {
  const int sw = (r32 >> 1) & 7; const LAS char* kb[4];
#pragma unroll
  for (int b = 0; b < 4; ++b) kb[b] = Ks + r32 * 384 + (((2 * b + hi) ^ sw) << 4);
  bf16x8 f0[3], f1[3];
#define KLD(d, slot) do { f0[slot] = *(const LAS bf16x8*)(kb[(d) & 3] + 128 * ((d) >> 2)); f1[slot] = *(const LAS bf16x8*)(kb[(d) & 3] + 128 * ((d) >> 2) + 32 * 384); } while (0)
  KLD(0, 0); KLD(1, 1);
  p0 = f32x16{}; p1 = f32x16{};
#pragma unroll
  for (int d0 = 0; d0 < DQK / 16; ++d0) {
    if (d0 + 2 < DQK / 16) KLD(d0 + 2, (d0 + 2) % 3);
    p0 = __builtin_amdgcn_mfma_f32_32x32x16_bf16(f0[d0 % 3], qr[d0], p0, 0, 0, 0);
    p1 = __builtin_amdgcn_mfma_f32_32x32x16_bf16(f1[d0 % 3], qr[d0], p1, 0, 0, 0);
    SBAR();
  }
#undef KLD
}
__device__ __forceinline__ int v_st(int k, int c) { const int kk = (k & ~0xC) | ((k & 4) << 1) | ((k & 8) >> 1); return ((kk >> 3) * 4 + (c >> 5)) * 512 + ((kk & 7) * 32 + (c & 31)) * 2; }
__device__ __forceinline__ int v_rd_base(int lane) { return ((lane & 3) << 3) | (((lane >> 2) & 3) << 6) | (((lane >> 4) & 1) << 5) | (((lane >> 5) & 1) << 8); }
constexpr int v_rd_off(int d0, int ks, int half) { return d0 * 512 + ks * 4096 + half * 2048; }
template <int OFF> __device__ __forceinline__ s16x4 tr_read(int vb) {
  s16x4 r; asm volatile("ds_read_b64_tr_b16 %0, %1 offset:%2" : "=&v"(r) : "v"(vb), "i"(OFF) : "memory"); return r;
}
template <int D0> __device__ __forceinline__ void pv_one(f32x16& od, int vb, bf16x8 pa0, bf16x8 pa1, bf16x8 pa2, bf16x8 pa3) {
  const s16x4 l0 = tr_read<v_rd_off(D0, 0, 0)>(vb), h0 = tr_read<v_rd_off(D0, 0, 1)>(vb), l1 = tr_read<v_rd_off(D0, 1, 0)>(vb), h1 = tr_read<v_rd_off(D0, 1, 1)>(vb);
  const s16x4 l2 = tr_read<v_rd_off(D0, 2, 0)>(vb), h2 = tr_read<v_rd_off(D0, 2, 1)>(vb), l3 = tr_read<v_rd_off(D0, 3, 0)>(vb), h3 = tr_read<v_rd_off(D0, 3, 1)>(vb);
  asm volatile("s_waitcnt lgkmcnt(0)" ::: "memory"); SBAR();
#define PK(L, H) (bf16x8){L[0], L[1], L[2], L[3], H[0], H[1], H[2], H[3]}
  od = __builtin_amdgcn_mfma_f32_32x32x16_bf16(pa0, PK(l0, h0), od, 0, 0, 0);
  od = __builtin_amdgcn_mfma_f32_32x32x16_bf16(pa1, PK(l1, h1), od, 0, 0, 0);
  od = __builtin_amdgcn_mfma_f32_32x32x16_bf16(pa2, PK(l2, h2), od, 0, 0, 0);
  od = __builtin_amdgcn_mfma_f32_32x32x16_bf16(pa3, PK(l3, h3), od, 0, 0, 0);
#undef PK
}
__device__ __forceinline__ void pv_d0(f32x16* o, int vb, bf16x8 pa0, bf16x8 pa1, bf16x8 pa2, bf16x8 pa3) {
  pv_one<0>(o[0], vb, pa0, pa1, pa2, pa3); pv_one<1>(o[1], vb, pa0, pa1, pa2, pa3); pv_one<2>(o[2], vb, pa0, pa1, pa2, pa3); pv_one<3>(o[3], vb, pa0, pa1, pa2, pa3);
}
__device__ __forceinline__ void attn_unit(const bf16* __restrict__ Qb, const bf16* __restrict__ Kh, const bf16* __restrict__ Vh, bf16* __restrict__ Ob, int seq, LAS char* lds) {
  int tid = threadIdx.x; asm volatile("" : "+v"(tid));
  const int wid = tid >> 6, lane = tid & 63, r32 = lane & 31, hi = lane >> 5;
  LAS char* V_lds = lds; LAS char* K_lds = lds + 2 * SHM_V;
  LAS float* ws = (LAS float*)(lds + 2 * SHM_V + 2 * SHM_K) + wid * 64; LAS float* li_l = ws; LAS float* al_l = ws + 32;
  float m_reg = -1e30f, l_reg = 0; f32x16 o[4] = {}; bf16x8 qr[DQK / 16];
  const bf16* Qw = Qb + (long)(wid * QBLK + r32) * LDQ + hi * 8;
#pragma unroll
  for (int d0 = 0; d0 < DQK / 16; ++d0) qr[d0] = *(const bf16x8*)(Qw + d0 * 16);
  unsigned koff[3], voff[2];
#pragma unroll
  for (int i = 0; i < 3; ++i) { const int q = (wid * 3 + i) * 1024 + 16 * lane, row = q / 384, cp = (q % 384) >> 4, c = (cp & ~7) | ((cp & 7) ^ ((row >> 1) & 7)); koff[i] = (unsigned)(row * (LDK * 2) + c * 16); }
#pragma unroll
  for (int i = 0; i < 2; ++i) { const int q = (wid * 2 + i) * 1024 + 16 * lane, sub = q >> 9, within = (q & 511) >> 1, kk = (sub >> 2) * 8 + (within >> 5), c = (sub & 3) * 32 + (within & 31);
    const int k = (kk & ~0xC) | ((kk & 4) << 1) | ((kk & 8) >> 1); voff[i] = (unsigned)(k * (LDV * 2) + c * 2); }
  const int vb0 = (int)(uintptr_t)V_lds + v_rd_base(lane);
  const int wpk = __builtin_amdgcn_readfirstlane(wid * 3072), wpv = __builtin_amdgcn_readfirstlane(wid * 2048);
#define SDMA(k0, b) do { const char* kg_ = (const char*)Kh + (size_t)(k0) * (LDK * 2); const char* vg_ = (const char*)Vh + (size_t)(k0) * (LDV * 2); \
    _Pragma("unroll") for (int i_ = 0; i_ < 3; ++i_) __builtin_amdgcn_global_load_lds((const unsigned*)(kg_ + koff[i_]), (LAS unsigned*)(K_lds + (b) * SHM_K + wpk + i_ * 1024), 16, 0, 0); \
    _Pragma("unroll") for (int i_ = 0; i_ < 2; ++i_) __builtin_amdgcn_global_load_lds((const unsigned*)(vg_ + voff[i_]), (LAS unsigned*)(V_lds + (b) * SHM_V + wpv + i_ * 1024), 16, 0, 0); } while (0)
#define SWAIT() asm volatile("s_waitcnt vmcnt(0)" ::: "memory")
#define RESC(a) do { if (__any((a) < 1.f)) { if (hi == 0) al_l[r32] = (a); asm volatile("s_waitcnt lgkmcnt(0)" ::: "memory"); \
    _Pragma("unroll") for (int d = 0; d < 4; ++d) _Pragma("unroll") for (int r = 0; r < 16; ++r) o[d][r] *= al_l[crow(r, hi)]; } } while (0)
  f32x16 p0, p1; float mn, al; bf16x8 pa0, pa1, pa2, pa3; const int NT = seq / KVBLK;
  SDMA(0, 0); SWAIT(); __syncthreads();
  for (int j = 0; j < NT; ++j) {
    const int bo = j & 1;
    if (j + 1 < NT) SDMA((j + 1) * KVBLK, bo ^ 1);
    SBAR(); qkt(p0, p1, K_lds + bo * SHM_K, qr, r32, hi);
    partialSM(p0, p1, m_reg, mn, al); RESC(al);
    finishSM(p0, p1, al, l_reg, pa0, pa1, pa2, pa3); SBAR();
    pv_d0(o, vb0 + bo * SHM_V, pa0, pa1, pa2, pa3);
    SWAIT(); __syncthreads();
  }
  if (hi == 0) li_l[r32] = l_reg; asm volatile("s_waitcnt lgkmcnt(0)" ::: "memory");
  float rli[16];
#pragma unroll
  for (int r = 0; r < 16; ++r) rli[r] = __builtin_amdgcn_rcpf(li_l[crow(r, hi)]);
  bf16* Ow = Ob + (long)(wid * QBLK) * LDO;
#pragma unroll
  for (int r = 0; r < 16; ++r) { const int orow = crow(r, hi);
#pragma unroll
    for (int d0 = 0; d0 < 4; ++d0) { const unsigned w = cvt_pk_bf16(o[d0][r] * rli[r], 0.f); Ow[(long)orow * LDO + d0 * 32 + r32] = (bf16)(w & 0xffffu); } }
  __syncthreads();
#undef SDMA
#undef SWAIT
#undef RESC
}
#undef SBAR
}

constexpr size_t MiB = 1u << 20;
constexpr size_t WS_CTL = 0, CTL_ZERO_BYTES = 1 * MiB;
constexpr size_t WS_MOD = 1 * MiB;
constexpr size_t WS_ROPE = 2 * MiB;
constexpr size_t WS_W1BD = 2 * MiB + 262144;
constexpr size_t WS_BC = 3 * MiB, WS_WC = 4 * MiB;
constexpr size_t WS_WIN = 5 * MiB, WS_WUQ = 21 * MiB, WS_WUKV = 24 * MiB, WS_WPOOL = 26 * MiB, WS_WOE = 27 * MiB, WS_WOO = 43 * MiB, WS_W1 = 59 * MiB, WS_W2 = 187 * MiB;
constexpr size_t WS_X = 315 * MiB;
constexpr size_t WS_H = 579 * MiB;
constexpr size_t WS_CAT = 711 * MiB;
constexpr size_t WS_BIG = 843 * MiB;
constexpr size_t WS_ACT = WS_BIG;
constexpr size_t WS_P = WS_BIG, WS_QN = WS_BIG + 132 * MiB, WS_KVN = WS_BIG + 165 * MiB, WS_POOLED = WS_BIG + 182 * MiB, WS_Q = WS_BIG + 248 * MiB, WS_KB = WS_BIG + 347 * MiB, WS_VB = WS_BIG + 446 * MiB;
constexpr size_t WS_PART = WS_BIG;
constexpr size_t WS_YT = WS_BIG, WS_G = WS_BIG + 256 * MiB, WS_YTC = WS_BIG + 512 * MiB;
constexpr size_t WS_PARTK = 1371 * MiB;
constexpr size_t WS_STATS = 1435 * MiB;
constexpr size_t STATS_ZERO_BYTES = 3 * MiB;
constexpr size_t WS_GM = 1438 * MiB;
constexpr size_t WS_BIASP = 1439 * MiB;
constexpr size_t WS_BIASA = 1440 * MiB;
constexpr size_t WS_BIASF = 1441 * MiB;
constexpr size_t WS_END = 1442 * MiB;
static_assert((size_t)DEPTH * 2 * T * 8 <= STATS_ZERO_BYTES && (size_t)DEPTH * 5 * DFF * 4 <= MiB, "stats / bias tables");
static_assert(WS_VB + (size_t)NB * NKEY * NH * DV * 2 <= WS_END && WS_YTC + (size_t)NB * D * 2 * CTXL * 2 <= WS_END && WS_ACT + (size_t)T * DFF * 2 <= WS_END, "ws map");
constexpr int CW_BAR = 4096;

constexpr int RING_BYTES = 131072, LDSCTL_OFF = RING_BYTES, MISC_OFF = LDSCTL_OFF + 320, LDS_BYTES = 147456;
constexpr int SCR_PER_WAVE = 8704, SILU_OFF = 73728;
static_assert(att::SHM_ATTN <= RING_BYTES && pg8::STAGE_BYTES <= RING_BYTES && 8 * SCR_PER_WAVE <= SILU_OFF && SILU_OFF + NMOD * D * 4 <= RING_BYTES, "LDS map");

#define RLX_AGENT __ATOMIC_RELAXED, __HIP_MEMORY_SCOPE_AGENT
#define LDS_WAIT() asm volatile("s_waitcnt lgkmcnt(0)" ::: "memory")

#define XB_TMO      128
#define XB_XCNT(j)  (256  + 64 * (j))
#define XB_XSUB(j)  (1280 + 64 * (j))
#define XB_XGEN(j)  (2304 + 64 * (j))
#define XB_TOP      3328
#define XB_TOPGEN   3392
#define XCD_BAR_WORDS 3456
#define XB_SPIN_CAP (1u << 22)
__device__ __forceinline__ unsigned xb_ld(unsigned* p)              { return __hip_atomic_load(p, __ATOMIC_RELAXED, __HIP_MEMORY_SCOPE_AGENT); }
__device__ __forceinline__ unsigned xb_add(unsigned* p, unsigned v) { return __hip_atomic_fetch_add(p, v, __ATOMIC_RELAXED, __HIP_MEMORY_SCOPE_AGENT); }
__device__ __forceinline__ unsigned xb_xcc_id() { return (unsigned)__builtin_amdgcn_s_getreg((3 << 11) | 20) & 0xFu; }
#define XB_SPIN(cond, bar) do { unsigned _sp = 0; while (cond) { __builtin_amdgcn_s_sleep(1); \
    if ((++_sp & 255u) == 0u) { if (xb_ld(&(bar)[XB_TMO])) break; if (_sp > XB_SPIN_CAP) { atomicAdd(&(bar)[XB_TMO], 1u); break; } } } } while (0)
struct XcdBarrier { unsigned* bar; unsigned x; volatile LAS unsigned* st; };
__device__ __forceinline__ XcdBarrier xcd_barrier_post(unsigned* bar, volatile LAS unsigned* st) {
    XcdBarrier b; b.bar = bar; b.x = xb_xcc_id(); b.st = st;
    if (threadIdx.x == 0) (void)xb_add(&bar[XB_XCNT(b.x)], 1u);
    return b;
}
__device__ __forceinline__ void xcd_barrier_complete(unsigned* bar, unsigned x, unsigned& nloc, unsigned& nx) {
    const unsigned G = gridDim.x * gridDim.y * gridDim.z;
    unsigned sum, cnt, mine, sp = 0u;
    for (;;) {
        sum = 0u; cnt = 0u; mine = 0u;
#pragma unroll
        for (unsigned j = 0; j < 16; ++j) { const unsigned c = xb_ld(&bar[XB_XCNT(j)]); sum += c; cnt += (c > 0u) ? 1u : 0u; mine = (j == x) ? c : mine; }
        if (sum == G) break;
        __builtin_amdgcn_s_sleep(1);
        if ((++sp & 255u) == 0u) { if (xb_ld(&bar[XB_TMO])) break; if (sp > XB_SPIN_CAP) { atomicAdd(&bar[XB_TMO], 1u); break; } }
    }
    nloc = mine > 0u ? mine : 1u; nx = cnt > 0u ? cnt : 1u;
}
__device__ __forceinline__ void xcd_barrier(const XcdBarrier& b) {
    asm volatile("s_waitcnt vmcnt(0)" ::: "memory");
    __syncthreads();
    int t0_ = threadIdx.x; asm volatile("" : "+v"(t0_));
    if (t0_ == 0) {
        unsigned* bar = b.bar;
        __builtin_amdgcn_s_waitcnt(0);
        unsigned nloc = b.st[0], nx = b.st[1];
        if (nloc == 0u) { xcd_barrier_complete(bar, b.x, nloc, nx); b.st[0] = nloc; b.st[1] = nx; }
        const unsigned old = xb_add(&bar[XB_XSUB(b.x)], 1u);
        const unsigned gen = old / nloc;
        if (old + 1u == (gen + 1u) * nloc) {
            __builtin_amdgcn_fence(__ATOMIC_RELEASE, "agent");
            asm volatile("s_waitcnt vmcnt(0)" ::: "memory");
            const unsigned og = xb_add(&bar[XB_TOP], 1u);
            const unsigned tg = og / nx;
            if (og + 1u == (tg + 1u) * nx) xb_add(&bar[XB_TOPGEN], 1u);
            else XB_SPIN(xb_ld(&bar[XB_TOPGEN]) == tg, bar);
            __builtin_amdgcn_fence(__ATOMIC_ACQUIRE, "agent");
            xb_add(&bar[XB_XGEN(b.x)], 1u);
            asm volatile("s_waitcnt vmcnt(0)" ::: "memory");
        } else {
            XB_SPIN(xb_ld(&bar[XB_XGEN(b.x)]) == gen, bar);
            __builtin_amdgcn_fence(__ATOMIC_ACQUIRE, "agent");
            asm volatile("s_waitcnt vmcnt(0)" ::: "memory");
        }
    }
    __syncthreads();
}

__device__ __forceinline__ float wave_sum(float v) {
#pragma unroll
    for (int o = 1; o < 64; o <<= 1) v += __shfl_xor(v, o);
    return v;
}
struct Ctx { LAS unsigned char* lds; int vcu, G, NGW; };
struct LaneV { int tid, lane, wave, gw; };
__device__ __forceinline__ LaneV lane_view(const Ctx& F) { LaneV v; int t = threadIdx.x; asm volatile("" : "+v"(t)); v.tid = t; v.lane = t & 63; v.wave = __builtin_amdgcn_readfirstlane(t >> 6); v.gw = F.vcu * 8 + v.wave; return v; }

__device__ __forceinline__ void transpose_item(const float* W, int ldw, bf16* WT, int ldt, int k0, int n0, LAS float* scr, int lane) {
    float tv[32];
#pragma unroll
    for (int i = 0; i < 32; ++i) { const int kk = 2 * i + (lane >> 5); tv[i] = W[(size_t)(k0 + kk) * ldw + n0 + (lane & 31)]; }
#pragma unroll
    for (int i = 0; i < 32; ++i) { const int kk = 2 * i + (lane >> 5); scr[kk * 33 + (lane & 31)] = tv[i]; }
    LDS_WAIT(); asm volatile("" ::: "memory");
    const int c = lane & 7;
#pragma unroll
    for (int j = 0; j < 4; ++j) { const int n = (lane >> 3) + 8 * j; const LAS float* s = scr + (8 * c) * 33 + n;
        u32x4 o; o.x = cvt_pk_bf16(s[0 * 33], s[1 * 33]); o.y = cvt_pk_bf16(s[2 * 33], s[3 * 33]); o.z = cvt_pk_bf16(s[4 * 33], s[5 * 33]); o.w = cvt_pk_bf16(s[6 * 33], s[7 * 33]);
        *(u32x4*)(WT + (size_t)(n0 + n) * ldt + k0 + 8 * c) = o; }
    LDS_WAIT(); asm volatile("" ::: "memory");
}
__device__ __forceinline__ bool transpose_group(int& r, const float* src, size_t sstr, int K, int N, bf16* dst, size_t dstr, int ldt, int cnt, LAS float* scr, int lane) {
    const int per = (K / 64) * (N / 32);
    if (r >= per * cnt) { r -= per * cnt; return false; }
    const int mi = r / per, it = r % per, nblk = N / 32, kb = it / nblk, nb = it % nblk;
    transpose_item(src + (size_t)mi * sstr, N, dst + (size_t)mi * dstr, ldt, 64 * kb, 32 * nb, scr, lane);
    return true;
}

__device__ __forceinline__ void prep_rows(const Ctx& F0, const float* Xa, const float* Xb, int r0, int r1, const float* gm, bf16* XG, u64* st, const float* part, const float* pgate, float* Xw) {
    const LaneV F = lane_view(F0);
    f32x4 v[4][2], vn[4][2];
#define PR_LOAD(dst, r_) do { const float* xr_ = ((r_) < TX ? Xa + (size_t)(r_) * D : Xb + (size_t)((r_) - TX) * D) + 8 * F.lane; \
        _Pragma("unroll") for (int q = 0; q < 4; ++q) _Pragma("unroll") for (int e = 0; e < 2; ++e) dst[q][e] = *(const f32x4*)(xr_ + 512 * q + 4 * e); } while (0)
    if (r0 + F.gw < r1) PR_LOAD(v, r0 + F.gw);
    for (int r = r0 + F.gw; r < r1; r += F0.NGW) {
        const int rn = r + F0.NGW;
        if (rn < r1) PR_LOAD(vn, rn);
        const bool isx = r < TX; const int j = isx ? (r >> 13) : 4; const float* mp = gm + (size_t)j * D;
        if (!isx && part) {
            const float* pr = part + (size_t)(r - TX) * D + 8 * F.lane;
#pragma unroll
            for (int q = 0; q < 4; ++q)
#pragma unroll
                for (int e = 0; e < 2; ++e) { f32x4 a = *(const f32x4*)(pr + 512 * q + 4 * e);
#pragma unroll
                    for (int sp = 1; sp < 8; ++sp) a += *(const f32x4*)(pr + (size_t)sp * TC * D + 512 * q + 4 * e);
                    v[q][e] += *(const f32x4*)(pgate + 8 * F.lane + 512 * q + 4 * e) * a;
                    *(f32x4*)(Xw + (size_t)r * D + 8 * F.lane + 512 * q + 4 * e) = v[q][e]; }
        }
        float ss = 0.f;
#pragma unroll
        for (int q = 0; q < 4; ++q)
#pragma unroll
            for (int e = 0; e < 2; ++e) ss += (v[q][e].x * v[q][e].x + v[q][e].y * v[q][e].y) + (v[q][e].z * v[q][e].z + v[q][e].w * v[q][e].w);
        ss = wave_sum(ss);
        if (F.lane == 0) st[r] = (u64)(ss * SS_FIX);
#pragma unroll
        for (int q = 0; q < 4; ++q) { const int c = 8 * F.lane + 512 * q; const f32x4 o0 = v[q][0] * *(const f32x4*)(mp + c), o1 = v[q][1] * *(const f32x4*)(mp + c + 4);
            u32x4 w; w.x = cvt_pk_bf16(o0.x, o0.y); w.y = cvt_pk_bf16(o0.z, o0.w); w.z = cvt_pk_bf16(o1.x, o1.y); w.w = cvt_pk_bf16(o1.z, o1.w);
            *(u32x4*)(XG + (size_t)r * D + c) = w; }
#pragma unroll
        for (int q = 0; q < 4; ++q)
#pragma unroll
            for (int e = 0; e < 2; ++e) v[q][e] = vn[q][e];
    }
#undef PR_LOAD
}
__device__ __forceinline__ void final_norm_rows(const Ctx& F0, const float* X, const float* gain, float* out) {
    const LaneV F = lane_view(F0);
    f32x4 v[4][2], vn[4][2];
#define FN_LOAD(dst, r_) do { const float* xr_ = X + (size_t)(r_) * D + 8 * F.lane; \
        _Pragma("unroll") for (int q = 0; q < 4; ++q) _Pragma("unroll") for (int e = 0; e < 2; ++e) dst[q][e] = *(const f32x4*)(xr_ + 512 * q + 4 * e); } while (0)
    if (F.gw < TX) FN_LOAD(v, F.gw);
    for (int r = F.gw; r < TX; r += F0.NGW) {
        const int rn = r + F0.NGW;
        if (rn < TX) FN_LOAD(vn, rn);
        float ss = 0.f;
#pragma unroll
        for (int q = 0; q < 4; ++q)
#pragma unroll
            for (int e = 0; e < 2; ++e) ss += (v[q][e].x * v[q][e].x + v[q][e].y * v[q][e].y) + (v[q][e].z * v[q][e].z + v[q][e].w * v[q][e].w);
        const float rs = 1.0f / sqrtf(wave_sum(ss) * (1.0f / D) + EPS);
#pragma unroll
        for (int q = 0; q < 4; ++q)
#pragma unroll
            for (int e = 0; e < 2; ++e) { const int c = 8 * F.lane + 512 * q + 4 * e; *(f32x4*)(out + (size_t)r * D + c) = (v[q][e] * rs) * *(const f32x4*)(gain + c); }
#pragma unroll
        for (int q = 0; q < 4; ++q)
#pragma unroll
            for (int e = 0; e < 2; ++e) v[q][e] = vn[q][e];
    }
#undef FN_LOAD
}
struct MidRow { u32x4 q; u32x2 kv; unsigned short rp; u32x2 w[30]; };
__device__ __forceinline__ void mid_load(MidRow& R, const bf16* P, int r, int lane) {
    const bf16* pr = P + (size_t)r * INWP; const bool isx = r < TX; const int t = isx ? (r & (SEQ - 1)) : ((r - TX) & (CTXL - 1)); const int n = isx ? SEQ : CTXL;
    R.q = *(const u32x4*)(pr + 8 * lane); R.kv = *(const u32x2*)(pr + QR + 4 * lane); R.rp = *(const unsigned short*)(pr + QR + KVR + lane);
    const bf16* seq0 = pr - (size_t)t * INWP + MLA_IN + 4 * lane;
#pragma unroll
    for (int g = 0; g < 4; ++g) { const int hw = 1 << g;
#pragma unroll
        for (int k = 0; k < 16; ++k) if (k < 2 * hw) { const int tt = t - hw + k; const int tc = tt < 0 ? 0 : (tt >= n ? n - 1 : tt); R.w[2 * hw - 2 + k] = *(const u32x2*)(seq0 + (size_t)tc * INWP + g * 256); } }
}
__device__ __forceinline__ void mid_compute(const MidRow& R, int r, int lane, const f32x4 qg0, const f32x4 qg1, const f32x4 kg0, const f32x2* rope, bf16* QN, bf16* KVN, bf16* KB, bf16* POOLED) {
    const bool isx = r < TX; const int b = isx ? (r >> 13) : ((r - TX) >> 8); const int t = isx ? (r & (SEQ - 1)) : ((r - TX) & (CTXL - 1)); const int n = isx ? SEQ : CTXL;
    { const u32x4 w = R.q; float q[8] = {bflo(w.x), bfhi(w.x), bflo(w.y), bfhi(w.y), bflo(w.z), bfhi(w.z), bflo(w.w), bfhi(w.w)}; float ss = 0.f;
#pragma unroll
      for (int e = 0; e < 8; ++e) ss += q[e] * q[e];
      const float rs = 1.0f / sqrtf(wave_sum(ss) * (1.0f / QR) + EPS); const f32x4 g0 = qg0, g1 = qg1;
      u32x4 o; o.x = cvt_pk_bf16(q[0] * rs * g0.x, q[1] * rs * g0.y); o.y = cvt_pk_bf16(q[2] * rs * g0.z, q[3] * rs * g0.w); o.z = cvt_pk_bf16(q[4] * rs * g1.x, q[5] * rs * g1.y); o.w = cvt_pk_bf16(q[6] * rs * g1.z, q[7] * rs * g1.w);
      *(u32x4*)(QN + (size_t)r * QR + 8 * lane) = o; }
    { const u32x2 w = R.kv; float q[4] = {bflo(w.x), bfhi(w.x), bflo(w.y), bfhi(w.y)}; float ss = (q[0] * q[0] + q[1] * q[1]) + (q[2] * q[2] + q[3] * q[3]);
      const float rs = 1.0f / sqrtf(wave_sum(ss) * (1.0f / KVR) + EPS); const f32x4 g0 = kg0;
      u32x2 o; o.x = cvt_pk_bf16(q[0] * rs * g0.x, q[1] * rs * g0.y); o.y = cvt_pk_bf16(q[2] * rs * g0.z, q[3] * rs * g0.w);
      *(u32x2*)(KVN + (size_t)r * KVR + 4 * lane) = o; }
    { float x = __uint_as_float((unsigned)R.rp << 16); const float xp = __shfl_xor(x, 16);
      if (isx) { const int pos = (lane >> 5) ? (t & 63) : (t >> 6); const f32x2 cs = rope[pos * 16 + (lane & 15)]; x = ((lane >> 4) & 1) ? (x * cs.x + xp * cs.y) : (x * cs.x - xp * cs.y); }
      const bf16 hv = (bf16)(cvt_pk_bf16(x, 0.f) & 0xffffu); bf16* kp = KB + ((size_t)b * NKEY + (isx ? CTXL + t : t)) * (NH * DQK) + DN + lane;
#pragma unroll
      for (int h = 0; h < NH; ++h) kp[h * DQK] = hv; }
#pragma unroll
    for (int g = 0; g < 4; ++g) { const int hw = 1 << g; float s[4] = {0.f, 0.f, 0.f, 0.f}; u32x2 wself = (u32x2){0u, 0u};
#pragma unroll
        for (int k = 0; k < 16; ++k) if (k < 2 * hw) { const int tt = t - hw + k; const float ok = (tt >= 0 && tt < n) ? 1.0f : 0.0f; const u32x2 wv = R.w[2 * hw - 2 + k];
            s[0] += ok * bflo(wv.x); s[1] += ok * bfhi(wv.x); s[2] += ok * bflo(wv.y); s[3] += ok * bfhi(wv.y); if (k == hw) wself = wv; }
        const int lo = t - hw < 0 ? 0 : t - hw, hi = t + hw > n ? n : t + hw; const float inv = 1.0f / (float)(hi - lo);
        u32x2 o; o.x = cvt_pk_bf16(s[0] * inv - bflo(wself.x), s[1] * inv - bfhi(wself.x)); o.y = cvt_pk_bf16(s[2] * inv - bflo(wself.y), s[3] * inv - bfhi(wself.y));
        *(u32x2*)(POOLED + (size_t)r * PW + g * 256 + 4 * lane) = o; }
}
__device__ __forceinline__ void mid_rows(const Ctx& F0, const bf16* P, int M, const float* qg, const float* kvg, const f32x2* rope, bf16* QN, bf16* KVN, bf16* KB, bf16* POOLED) {
    const LaneV F = lane_view(F0); const int lane = F.lane, step = F0.NGW;
    const f32x4 qg0 = *(const f32x4*)(qg + 8 * lane), qg1 = *(const f32x4*)(qg + 8 * lane + 4), kg0 = *(const f32x4*)(kvg + 4 * lane);
    MidRow A, B;
    int r = F.gw;
    if (r < M) mid_load(A, P, r, lane);
    for (; r < M; r += 2 * step) {
        if (r + step < M) mid_load(B, P, r + step, lane);
        __builtin_amdgcn_sched_barrier(0);
        mid_compute(A, r, lane, qg0, qg1, kg0, rope, QN, KVN, KB, POOLED);
        __builtin_amdgcn_sched_barrier(0);
        if (r + 2 * step < M) mid_load(A, P, r + 2 * step, lane);
        __builtin_amdgcn_sched_barrier(0);
        if (r + step < M) mid_compute(B, r + step, lane, qg0, qg1, kg0, rope, QN, KVN, KB, POOLED);
        __builtin_amdgcn_sched_barrier(0);
    }
}

struct Args { const float* in[20]; float* out; unsigned char* ws; };
#define KARG() ({ const __attribute__((address_space(4))) Args* k_ = (const __attribute__((address_space(4))) Args*)__builtin_amdgcn_kernarg_segment_ptr(); asm volatile("" : "+s"(k_)); k_; })
#define KIN(i) ({ const GAS float* q_ = (const GAS float*)(KARG()->in[i]); asm volatile("" : "+s"(q_)); (const float*)q_; })
#define KOUT() ({ GAS float* q_ = (GAS float*)(KARG()->out); asm volatile("" : "+s"(q_)); (float*)q_; })
enum { I_X = 0, I_C, I_CTX, I_CCTX, I_WMOD, I_BMOD, I_NORM1, I_NORM2, I_WIN, I_QNORM, I_WUQ, I_KVNORM, I_WUKV, I_WPOOL, I_PSCALE, I_WOE, I_WOO, I_W1, I_W2, I_FNORM };

__device__ __forceinline__ void prologue(const Ctx& F0) {
    unsigned char* ws; { GAS unsigned char* p_ = (GAS unsigned char*)KARG()->ws; asm volatile("" : "+s"(p_)); ws = (unsigned char*)p_; }
    struct PF { LAS unsigned char* lds; int tid, lane, wave, gw, NGW, gt, NGT; };
#define PFV() ({ PF f_; const LaneV v_ = lane_view(F0); f_.lds = F0.lds; f_.tid = v_.tid; f_.lane = v_.lane; f_.wave = v_.wave; f_.gw = v_.gw; f_.NGW = F0.NGW; f_.gt = F0.vcu * 512 + v_.tid; f_.NGT = F0.G * 512; f_; })
    LAS float* sl = (LAS float*)(F0.lds + SILU_OFF);
    { const PF F = PFV(); for (int i = F.tid; i < NMOD * D; i += 512) { const float v = i < NB * D ? KIN(I_C)[i] : KIN(I_CCTX)[i - NB * D]; sl[i] = v / (1.0f + __expf(-v)); } }
    __syncthreads();
    { const PF F = PFV(); float* PART = (float*)(ws + WS_PART); const float* wm = KIN(I_WMOD);
      for (int it = F.gw; it < DEPTH * 48 * 32; it += F.NGW) { const int l = it / 1536, r = it % 1536, nc = r % 48, kc = r / 48; const int n = nc * 256 + 4 * F.lane;
          f32x4 acc[NMOD];
#pragma unroll
          for (int j = 0; j < NMOD; ++j) acc[j] = (f32x4){0.f, 0.f, 0.f, 0.f};
          const float* wp = wm + ((size_t)l * D + kc * 64) * MODW + n;
          for (int kk = 0; kk < 64; kk += 16) { f32x4 w[16];
#pragma unroll
              for (int u = 0; u < 16; ++u) w[u] = *(const f32x4*)(wp + (size_t)(kk + u) * MODW);
#pragma unroll
              for (int j = 0; j < NMOD; ++j)
#pragma unroll
                  for (int u4 = 0; u4 < 4; ++u4) { const f32x4 s = *(const LAS f32x4*)(sl + j * D + kc * 64 + kk + 4 * u4); acc[j] += w[4 * u4] * s.x + w[4 * u4 + 1] * s.y + w[4 * u4 + 2] * s.z + w[4 * u4 + 3] * s.w; } }
#pragma unroll
          for (int j = 0; j < NMOD; ++j) *(f32x4*)(PART + (((size_t)kc * DEPTH + l) * NMOD + j) * MODW + n) = acc[j]; } }
    { const PF F = PFV(); LAS float* scr = (LAS float*)(F.lds + F.wave * SCR_PER_WAVE);
      constexpr int NIT = 2 * (32 * 58) + 2 * (8 * 48) + 2 * (4 * 64) + 8 * (4 * 8) + 2 * (32 * 64) + 2 * (32 * 64) + 4 * (32 * 256) + 4 * (128 * 64);
      for (int it = F.gw; it < NIT; it += F.NGW) { int r = it;
          if (transpose_group(r, KIN(I_WIN), (size_t)D * INW, D, INW, (bf16*)(ws + WS_WIN), (size_t)INWP * D, D, 2, scr, F.lane)) continue;
          if (transpose_group(r, KIN(I_WUQ), (size_t)QR * NH * DQK, QR, NH * DQK, (bf16*)(ws + WS_WUQ), (size_t)NH * DQK * QR, QR, 2, scr, F.lane)) continue;
          if (transpose_group(r, KIN(I_WUKV), (size_t)KVR * NH * 256, KVR, NH * 256, (bf16*)(ws + WS_WUKV), (size_t)NH * 256 * KVR, KVR, 2, scr, F.lane)) continue;
          if (transpose_group(r, KIN(I_WPOOL), (size_t)256 * 256, 256, 256, (bf16*)(ws + WS_WPOOL), (size_t)256 * 256, 256, 8, scr, F.lane)) continue;
          if (transpose_group(r, KIN(I_WOE), (size_t)D * D, D, D, (bf16*)(ws + WS_WOE), (size_t)D * D, D, 2, scr, F.lane)) continue;
          if (transpose_group(r, KIN(I_WOO), (size_t)D * D, D, D, (bf16*)(ws + WS_WOO), (size_t)D * D, D, 2, scr, F.lane)) continue;
          if (transpose_group(r, KIN(I_W1), (size_t)D * DFF, D, DFF, (bf16*)(ws + WS_W1), (size_t)DFF * D, D, 4, scr, F.lane)) continue;
          transpose_group(r, KIN(I_W2), (size_t)DFF * D, DFF, D, (bf16*)(ws + WS_W2), (size_t)D * DFF, DFF, 4, scr, F.lane); } }
    { const PF F = PFV(); const int gt = F.gt, NGT = F.NGT; constexpr int PADV = (INWP - INW) * D * 2 / 16;
      for (int i = gt; i < 2 * PADV; i += NGT) { const int li = i / PADV, p = i % PADV; *(u32x4*)(ws + WS_WIN + (size_t)li * INWP * D * 2 + (size_t)INW * D * 2 + (size_t)p * 16) = (u32x4){0u, 0u, 0u, 0u}; } }
    { const PF F = PFV(); const int gt = F.gt, NGT = F.NGT;
    for (int i = gt; i < 128 * 16; i += NGT) { const int pos = i >> 4, f = i & 15; const float inv = powf(10000.0f, -2.0f * (float)f / 32.0f); const float ang = (float)pos * inv; ((f32x2*)(ws + WS_ROPE))[i] = (f32x2){cosf(ang), sinf(ang)}; } }
    { const PF F = PFV(); const int gt = F.gt, NGT = F.NGT;
    for (int i = gt; i < 1024 * 512; i += NGT) { const int row = i >> 9, c = i & 511, ri = row >> 9, m = row & 511; float sn, cs; sincospif((float)((c * m) & 511) * (1.0f / 256.0f), &sn, &cs);
        const float v = (ri ? -sn : cs) * 0.04419417382415922f; ((bf16*)(ws + WS_BC))[i] = (bf16)(cvt_pk_bf16(v, 0.f) & 0xffffu); } }
    { const PF F = PFV(); const int gt = F.gt, NGT = F.NGT;
    for (int i = gt; i < 256 * 512; i += NGT) { const int k = i >> 9, col = i & 511, ri = col >> 8, j = col & 255; float sn, cs; sincospif((float)((j * k) & 255) * (1.0f / 128.0f), &sn, &cs);
        const float v = (ri ? sn : cs) * 0.0625f; ((bf16*)(ws + WS_WC))[i] = (bf16)(cvt_pk_bf16(v, 0.f) & 0xffffu); } }
    { const PF F = PFV(); const int gt = F.gt, NGT = F.NGT;
    for (int i = gt; i < 256 * 256; i += NGT) { const int c = i >> 8, kk = i & 255, k1 = c >> 3, ro = (c >> 2) & 1, js = c & 3, js2 = kk >> 6, ri = (kk >> 5) & 1, j1 = kk & 31; float sn, cs; sincospif((float)((j1 * k1) & 31) * (1.0f / 16.0f), &sn, &cs);
        float v = (ro == ri) ? cs : (ro == 0 ? sn : -sn); v = (js == js2) ? v * 0.17677669529663687f : 0.f; ((bf16*)(ws + WS_W1BD))[i] = (bf16)(cvt_pk_bf16(v, 0.f) & 0xffffu); } }
#undef PFV
}
__device__ __forceinline__ void mod_reduce(const Ctx& F0) {
    const LaneV F = lane_view(F0); unsigned char* ws; { GAS unsigned char* p_ = (GAS unsigned char*)KARG()->ws; asm volatile("" : "+s"(p_)); ws = (unsigned char*)p_; }
    const float* PART = (const float*)(ws + WS_PART); float* MOD = (float*)(ws + WS_MOD); float* GM = (float*)(ws + WS_GM); const float* bm = KIN(I_BMOD);
    for (int i = F0.vcu * 512 + F.tid; i < DEPTH * NMOD * MODW / 4; i += F0.G * 512) { const int e = i * 4, l = e / (NMOD * MODW), j = (e / MODW) % NMOD, n = e % MODW;
        f32x4 a = *(const f32x4*)(bm + (size_t)l * MODW + n);
        for (int kc = 0; kc < 32; ++kc) a += *(const f32x4*)(PART + (size_t)kc * DEPTH * NMOD * MODW + e);
        *(f32x4*)(MOD + e) = a;
        const int chunk = n / D, c = n % D;
        if (chunk == 1 || chunk == 4) { const int which = chunk == 4; const f32x4 g = *(const f32x4*)((which ? KIN(I_NORM2) : KIN(I_NORM1)) + (size_t)l * D + c);
            *(f32x4*)(GM + (((size_t)l * 2 + which) * NMOD + j) * D + c) = g * (a + 1.0f); } }
}
__device__ __forceinline__ void bias_rows(const Ctx& F0) {
    const LaneV F = lane_view(F0); unsigned char* ws; { GAS unsigned char* p_ = (GAS unsigned char*)KARG()->ws; asm volatile("" : "+s"(p_)); ws = (unsigned char*)p_; }
    const float* MOD = (const float*)(ws + WS_MOD); LAS float* shl = (LAS float*)F0.lds;
    for (int set = 0; set < 8; ++set) {
        const bf16* wbase; const float* sh; float* out; int nrows, ostride;
        if (set < 2) { const int li = set; wbase = (const bf16*)(ws + WS_WIN) + (size_t)li * INWP * D; sh = MOD + (size_t)(2 * li) * NMOD * MODW; out = (float*)(ws + WS_BIASP) + (size_t)li * NMOD * INWP; nrows = INWP; ostride = INWP; }
        else if (set < 6) { const int l = set - 2; wbase = (const bf16*)(ws + WS_W1) + (size_t)l * DFF * D; sh = MOD + (size_t)l * NMOD * MODW + 3 * D; out = (float*)(ws + WS_BIASA) + (size_t)l * NMOD * DFF; nrows = DFF; ostride = DFF; }
        else { const int li = set - 6; wbase = (const bf16*)(ws + WS_BC); sh = MOD + (size_t)(2 * li + 1) * NMOD * MODW; out = (float*)(ws + WS_BIASF) + (size_t)li * NMOD * 4096; nrows = 4096; ostride = 4096; }
        __syncthreads();
        for (int i = F.tid; i < NMOD * D / 4; i += 512) { const int j = i / (D / 4), c = (i % (D / 4)) * 4; *(LAS f32x4*)(shl + j * D + c) = *(const f32x4*)(sh + (size_t)j * MODW + c); }
        __syncthreads();
        if (set < 6) {
            for (int n = F.gw; n < nrows; n += F0.NGW) { const bf16* wrow = wbase + (size_t)n * D + 8 * F.lane; u32x4 w[4];
#pragma unroll
                for (int q = 0; q < 4; ++q) w[q] = *(const u32x4*)(wrow + 512 * q);
                float acc[NMOD];
#pragma unroll
                for (int j = 0; j < NMOD; ++j) acc[j] = 0.f;
#pragma unroll
                for (int q = 0; q < 4; ++q) { const float wv[8] = {bflo(w[q].x), bfhi(w[q].x), bflo(w[q].y), bfhi(w[q].y), bflo(w[q].z), bfhi(w[q].z), bflo(w[q].w), bfhi(w[q].w)};
#pragma unroll
                    for (int j = 0; j < NMOD; ++j) { const f32x4 s0 = *(const LAS f32x4*)(shl + j * D + 8 * F.lane + 512 * q), s1 = *(const LAS f32x4*)(shl + j * D + 8 * F.lane + 512 * q + 4);
                        acc[j] += (wv[0] * s0.x + wv[1] * s0.y) + (wv[2] * s0.z + wv[3] * s0.w) + (wv[4] * s1.x + wv[5] * s1.y) + (wv[6] * s1.z + wv[7] * s1.w); } }
#pragma unroll
                for (int j = 0; j < NMOD; ++j) { const float t = wave_sum(acc[j]); if (F.lane == 0) out[(size_t)j * ostride + n] = t; } }
        } else {
            for (int n = F.gw; n < nrows; n += F0.NGW) { const int g = n >> 10, row = n & 1023; const u32x4 w = *(const u32x4*)(wbase + (size_t)row * 512 + 8 * F.lane);
                const float wv[8] = {bflo(w.x), bfhi(w.x), bflo(w.y), bfhi(w.y), bflo(w.z), bfhi(w.z), bflo(w.w), bfhi(w.w)};
#pragma unroll
                for (int j = 0; j < NMOD; ++j) { const f32x4 s0 = *(const LAS f32x4*)(shl + j * D + g * 512 + 8 * F.lane), s1 = *(const LAS f32x4*)(shl + j * D + g * 512 + 8 * F.lane + 4);
                    float a = (wv[0] * s0.x + wv[1] * s0.y) + (wv[2] * s0.z + wv[3] * s0.w) + (wv[4] * s1.x + wv[5] * s1.y) + (wv[6] * s1.z + wv[7] * s1.w);
                    a = wave_sum(a); if (F.lane == 0) out[(size_t)j * ostride + n] = a; } }
        }
    }
    __syncthreads();
}
struct MapPool {
    const char* A; const char* B; int nM;
    __device__ __forceinline__ int total() const { return nM * 4; }
    __device__ __forceinline__ void get(int L, pg8::Unit& u) const { const int pm = L >> 2, g = L & 3; u.pm = pm; u.pn = g; u.a = A + (size_t)pm * 256 * (PW * 2) + g * 512; u.b = B + (size_t)g * 256 * 256 * 2; }
};
struct MapF1 {
    const char* Bc; const char* H;
    __device__ __forceinline__ int total() const { return NB * 4 * 32 * 4; }
    __device__ __forceinline__ void get(int L, pg8::Unit& u) const { const int pmr = L & 3, jt = (L >> 2) & 31, g = (L >> 7) & 3, b = L >> 9;
        u.a = Bc + (size_t)pmr * 256 * 1024; u.b = H + ((size_t)b * SEQ + jt * 8) * (D * 2) + g * 1024; u.pm = (b * 4 + g) * 4 + pmr; u.pn = jt; }
};
struct MapYTC {
    const char* Bc; const char* H;
    __device__ __forceinline__ int total() const { return NB * 4 * 4; }
    __device__ __forceinline__ void get(int L, pg8::Unit& u) const { const int pmr = L & 3, g = (L >> 2) & 3, b = L >> 4;
        u.a = Bc + (size_t)pmr * 256 * 1024; u.b = H + ((size_t)TX + b * CTXL) * (D * 2) + g * 1024; u.pm = b * 8 + g * 2 + (pmr & 1); u.pn = pmr >> 1; }
};
struct MapF3 {
    const char* WC; const char* G;
    __device__ __forceinline__ int total() const { return NB * 32 * 8; }
    __device__ __forceinline__ void get(int L, pg8::Unit& u) const { const int pn = L & 7, bk = L >> 3; u.a = WC; u.b = G + ((size_t)bk * D + pn * 256) * 1024; u.pm = bk; u.pn = pn; }
};
struct MapFC {
    const char* WC; const char* YTC;
    __device__ __forceinline__ int total() const { return NB * 8; }
    __device__ __forceinline__ void get(int L, pg8::Unit& u) const { const int b = L >> 3, pn = L & 7; u.a = WC; u.b = YTC + ((size_t)b * D + pn * 256) * 1024; u.pm = 128 + b; u.pn = pn; }
};

__global__ void __launch_bounds__(512, 2) fwd(Args args) {
    extern __shared__ __attribute__((aligned(16))) unsigned char lds_raw[];
    Ctx F; F.lds = (LAS unsigned char*)lds_raw;
    F.G = gridDim.x; { const int bx = blockIdx.x; F.vcu = (F.G % 8 == 0) ? (bx % 8) * (F.G / 8) + bx / 8 : bx; }
    F.NGW = F.G * 8;
    for (int u = threadIdx.x; u < (LDS_BYTES - LDSCTL_OFF) / 4; u += 512) ((LAS unsigned*)(F.lds + LDSCTL_OFF))[u] = 0u;
    __syncthreads();
    volatile LAS unsigned* MISC = (volatile LAS unsigned*)(F.lds + MISC_OFF);
    (void)xcd_barrier_post((unsigned*)(args.ws + WS_CTL) + CW_BAR, MISC + 8);
#define bx ({ int b_ = (int)blockIdx.x; asm volatile("" : "+s"(b_)); b_; })
#define WSL() ({ GAS unsigned char* p_ = (GAS unsigned char*)KARG()->ws; asm volatile("" : "+s"(p_)); (unsigned char*)p_; })
#define GRID_BAR() do { XcdBarrier b_; b_.bar = (unsigned*)(WSL() + WS_CTL) + CW_BAR; b_.x = xb_xcc_id(); b_.st = (volatile LAS unsigned*)(F.lds + MISC_OFF) + 8; xcd_barrier(b_); } while (0)
#define XP(w) ((float*)((w) + WS_X))
#define HP(w) ((bf16*)((w) + WS_H))
#define CATP(w) ((bf16*)((w) + WS_CAT))
#define MODP(w, l) ((const float*)((w) + WS_MOD) + (size_t)(l) * NMOD * MODW)
#define STP(w, l, which) ((u64*)((w) + WS_STATS) + (size_t)((l) * 2 + (which)) * T)
#define GMP(w, l, which) ((const float*)((w) + WS_GM) + (size_t)((l) * 2 + (which)) * NMOD * D)

    prologue(F);
    GRID_BAR();
    mod_reduce(F);
    GRID_BAR();
    bias_rows(F);
    { unsigned char* ws = WSL(); prep_rows(F, KIN(I_X), KIN(I_CTX), 0, T, GMP(ws, 0, 0), HP(ws), STP(ws, 0, 0), nullptr, nullptr, nullptr); }
    GRID_BAR();

    for (int l = 0; l < DEPTH; ++l) {
        const bool even = (l & 1) == 0; const int li = l >> 1;
        const bool ctx_in = l <= 2, ctx_out = l <= 1;
        const int Min = ctx_in ? T : TX, nMin = Min / 256, Mout = ctx_out ? T : TX, nMout = Mout / 256;
        if (even) {
            {
                unsigned char* ws = WSL();
                pg8::Strided<pg8::MapStd> S{{(const char*)HP(ws), (const char*)(ws + WS_WIN + (size_t)li * INWP * D * 2), 256l * D * 2, 256l * D * 2, nMin, INWP / 256}, F.G, bx};
                pg8::gemm_phase(F.lds, pg8::Geo{D, D * 2, D * 2}, S, pg8::EpiNormStore{(bf16*)(ws + WS_P), INWP, STP(ws, l, 0), (const float*)(ws + WS_BIASP) + (size_t)li * NMOD * INWP, INWP});
            }
            GRID_BAR();
            { unsigned char* ws = WSL();
              mid_rows(F, (const bf16*)(ws + WS_P), Min, KIN(I_QNORM) + (size_t)li * QR, KIN(I_KVNORM) + (size_t)li * KVR, (const f32x2*)(ws + WS_ROPE), (bf16*)(ws + WS_QN), (bf16*)(ws + WS_KVN), (bf16*)(ws + WS_KB), (bf16*)(ws + WS_POOLED)); }
            GRID_BAR();
            {
                unsigned char* ws = WSL();
                pg8::Strided<pg8::MapStd> S{{(const char*)(ws + WS_QN), (const char*)(ws + WS_WUQ + (size_t)li * NH * DQK * QR * 2), 256l * QR * 2, 256l * QR * 2, nMout, NH * DQK / 256}, F.G, bx};
                pg8::gemm_phase(F.lds, pg8::Geo{QR, QR * 2, QR * 2}, S, pg8::EpiQ{(bf16*)(ws + WS_Q), (const f32x2*)(ws + WS_ROPE)});
            }
            {
                unsigned char* ws = WSL();
                pg8::Strided<pg8::MapStd> S{{(const char*)(ws + WS_KVN), (const char*)(ws + WS_WUKV + (size_t)li * NH * 256 * KVR * 2), 256l * KVR * 2, 256l * KVR * 2, nMin, NH}, F.G, bx};
                pg8::gemm_phase(F.lds, pg8::Geo{KVR, KVR * 2, KVR * 2}, S, pg8::EpiKV{(bf16*)(ws + WS_KB), (bf16*)(ws + WS_VB)});
            }
            {
                unsigned char* ws = WSL();
                pg8::Strided<MapPool> S{{(const char*)(ws + WS_POOLED), (const char*)(ws + WS_WPOOL + (size_t)li * 4 * 256 * 256 * 2), nMout}, F.G, bx};
                pg8::gemm_phase(F.lds, pg8::Geo{256, PW * 2, 256 * 2}, S, pg8::EpiPool{CATP(ws), KIN(I_PSCALE) + (size_t)li * PW});
            }
            GRID_BAR();
            {
                unsigned char* ws = WSL();
                const bf16* Q = (const bf16*)(ws + WS_Q); const bf16* KB = (const bf16*)(ws + WS_KB); const bf16* VB = (const bf16*)(ws + WS_VB); bf16* CAT = CATP(ws);
                const int nun = ctx_out ? 1024 + 32 : 1024;
                for (int i = 0;; ++i) { const int id = i * F.G + F.vcu; if (id >= nun) break;
                    int row0, b, h, seq;
                    if (id < 1024) { const int bh = id >> 5, qb = id & 31; b = bh >> 3; h = bh & 7; row0 = b * SEQ + qb * 256; seq = NKEY; }
                    else { const int c = id - 1024; b = c >> 3; h = c & 7; row0 = TX + b * CTXL; seq = CTXL; }
                    att::attn_unit(Q + (size_t)row0 * (NH * DQK) + h * DQK, KB + (size_t)b * NKEY * (NH * DQK) + h * DQK, VB + (size_t)b * NKEY * (NH * DV) + h * DV,
                                   CAT + (size_t)row0 * D + h * DV, seq, (LAS char*)F.lds); }
            }
            GRID_BAR();
        } else {
            {
                unsigned char* ws = WSL();
                pg8::Strided<MapF1> S{{(const char*)(ws + WS_BC), (const char*)HP(ws)}, F.G, bx};
                pg8::gemm_phase<pg8::EpiYt, pg8::Strided<MapF1>, true, true>(F.lds, pg8::Geo{512, 1024, D * 2}, S, pg8::EpiYt{(bf16*)(ws + WS_YT), STP(ws, l, 0), (const float*)(ws + WS_BIASF) + (size_t)li * NMOD * 4096});
            }
            if (ctx_out) {
                unsigned char* ws = WSL();
                pg8::Strided<MapYTC> S{{(const char*)(ws + WS_BC), (const char*)HP(ws)}, F.G, bx};
                pg8::gemm_phase(F.lds, pg8::Geo{512, 1024, D * 2}, S, pg8::EpiYtc{(bf16*)(ws + WS_YTC), STP(ws, l, 0), (const float*)(ws + WS_BIASF) + (size_t)li * NMOD * 4096});
            }
            GRID_BAR();
            {
                unsigned char* ws = WSL();
                pg8::Strided<pg8::MapStd> S{{(const char*)(ws + WS_YT), (const char*)(ws + WS_W1BD), 256l * 512, 0l, NB * D * 64 / 256, 1}, F.G, bx};
                pg8::gemm_phase(F.lds, pg8::Geo{256, 512, 512}, S, pg8::EpiF2{(bf16*)(ws + WS_G)});
            }
            GRID_BAR();
            {
                unsigned char* ws = WSL();
                pg8::Strided<MapF3> S{{(const char*)(ws + WS_WC), (const char*)(ws + WS_G)}, F.G, bx};
                pg8::gemm_phase(F.lds, pg8::Geo{512, 1024, 1024}, S, pg8::EpiF3{CATP(ws)});
            }
            if (ctx_out) {
                unsigned char* ws = WSL();
                pg8::Strided<MapFC> S{{(const char*)(ws + WS_WC), (const char*)(ws + WS_YTC)}, F.G, bx};
                pg8::gemm_phase(F.lds, pg8::Geo{2 * CTXL, 2 * CTXL * 2, 2 * CTXL * 2}, S, pg8::EpiStore<0>{CATP(ws), D});
            }
            GRID_BAR();
        }
        {
            unsigned char* ws = WSL();
            const char* Wo = even ? (const char*)(ws + WS_WOE + (size_t)li * D * D * 2) : (const char*)(ws + WS_WOO + (size_t)li * D * D * 2);
            pg8::Strided<pg8::MapStd> S{{(const char*)CATP(ws), Wo, 256l * D * 2, 256l * D * 2, TX / 256, D / 256}, F.G, bx};
            pg8::gemm_phase(F.lds, pg8::Geo{D, D * 2, D * 2}, S, pg8::EpiResidN{l == 0 ? KIN(I_X) : XP(ws), XP(ws), MODP(ws, l) + 2 * D, GMP(ws, l, 1), HP(ws), STP(ws, l, 1), l != 0, 1});
        }
        if (ctx_out) {
            unsigned char* ws = WSL();
            const char* Wo = even ? (const char*)(ws + WS_WOE + (size_t)li * D * D * 2) : (const char*)(ws + WS_WOO + (size_t)li * D * D * 2);
            pg8::Strided<pg8::MapSplitK> S{{(const char*)CATP(ws), Wo, 256l * D * 2, 256l * D * 2, (D / 8) * 2l, (D / 8) * 2l}, F.G, bx};
            pg8::gemm_phase(F.lds, pg8::Geo{D / 8, D * 2, D * 2}, S, pg8::EpiPartF32{(float*)(ws + WS_PARTK)});
        }
        GRID_BAR();
        if (ctx_out) {
            unsigned char* ws = WSL(); const float* Xb = l == 0 ? KIN(I_CTX) : XP(ws) + (size_t)TX * D;
            prep_rows(F, nullptr, Xb, TX, T, GMP(ws, l, 1), HP(ws), STP(ws, l, 1), (const float*)(ws + WS_PARTK), MODP(ws, l) + 4 * MODW + 2 * D, XP(ws));
            GRID_BAR();
        }
        {
            unsigned char* ws = WSL();
            pg8::Strided<pg8::MapStd> S{{(const char*)HP(ws), (const char*)(ws + WS_W1 + (size_t)l * DFF * D * 2), 256l * D * 2, 256l * D * 2, nMout, DFF / 256}, F.G, bx};
            pg8::gemm_phase(F.lds, pg8::Geo{D, D * 2, D * 2}, S, pg8::EpiAct{(bf16*)(ws + WS_ACT), STP(ws, l, 1), (const float*)(ws + WS_BIASA) + (size_t)l * NMOD * DFF});
        }
        GRID_BAR();
        {
            unsigned char* ws = WSL();
            pg8::Strided<pg8::MapStd> S{{(const char*)(ws + WS_ACT), (const char*)(ws + WS_W2 + (size_t)l * D * DFF * 2), 256l * DFF * 2, 256l * DFF * 2, TX / 256, D / 256}, F.G, bx};
            pg8::gemm_phase(F.lds, pg8::Geo{DFF, 64, DFF * 2, 256 * 128, 128, 256 * 64}, S, pg8::EpiResidN{XP(ws), l + 1 < DEPTH ? XP(ws) : KOUT(), MODP(ws, l) + 5 * D, GMP(ws, l + 1, 0), HP(ws), l + 1 < DEPTH ? STP(ws, l + 1, 0) : nullptr, 1, l + 1 < DEPTH});
        }
        if (ctx_out) {
            unsigned char* ws = WSL();
            pg8::Strided<pg8::MapSplitK> S{{(const char*)(ws + WS_ACT), (const char*)(ws + WS_W2 + (size_t)l * D * DFF * 2), 256l * DFF * 2, 256l * DFF * 2, (DFF / 8 / 64) * 256l * 128, (DFF / 8) * 2l}, F.G, bx};
            pg8::gemm_phase(F.lds, pg8::Geo{DFF / 8, 64, DFF * 2, 256 * 128, 128, 256 * 64}, S, pg8::EpiPartF32{(float*)(ws + WS_PARTK)});
        }
        GRID_BAR();
        if (ctx_out) {
            unsigned char* ws = WSL();
            prep_rows(F, nullptr, XP(ws) + (size_t)TX * D, TX, T, GMP(ws, l + 1, 0), HP(ws), STP(ws, l + 1, 0), (const float*)(ws + WS_PARTK), MODP(ws, l) + 4 * MODW + 5 * D, XP(ws));
            GRID_BAR();
        }
    }
    final_norm_rows(F, KOUT(), KIN(I_FNORM), KOUT());
}

extern "C" void kernel_launch(void* const* d_in, const int* in_sizes, int n_in, void* d_out, int out_size, void* d_ws, size_t ws_size, hipStream_t stream) {
    static int grid = 0;
    if (grid == 0) {
        if (n_in != 20 || in_sizes[0] != TX * D || out_size != TX * D || ws_size < WS_END) { fprintf(stderr, "kernel_launch: shape mismatch: n_in %d in0 %d out %d ws %zu (need %zu)\n", n_in, n_in > 0 ? in_sizes[0] : -1, out_size, ws_size, (size_t)WS_END); grid = -1; return; }
        int dev = 0, cus = 0, per_cu = 0;
        if (hipGetDevice(&dev) != hipSuccess || hipDeviceGetAttribute(&cus, hipDeviceAttributeMultiprocessorCount, dev) != hipSuccess) { fprintf(stderr, "kernel_launch: device query failed\n"); grid = -1; return; }
        if (hipFuncSetAttribute((const void*)fwd, hipFuncAttributeMaxDynamicSharedMemorySize, LDS_BYTES) != hipSuccess) { fprintf(stderr, "kernel_launch: hipFuncSetAttribute failed\n"); grid = -1; return; }
        if (hipOccupancyMaxActiveBlocksPerMultiprocessor(&per_cu, (const void*)fwd, 512, LDS_BYTES) != hipSuccess || per_cu < 1) fprintf(stderr, "kernel_launch: note: occupancy query reports %d workgroups per CU\n", per_cu);
        (void)hipGetLastError();
        grid = cus;
    }
    if (grid < 0) return;
    if (hipMemsetAsync((char*)d_ws + WS_CTL, 0, CTL_ZERO_BYTES, stream) != hipSuccess || hipMemsetAsync((char*)d_ws + WS_STATS, 0, STATS_ZERO_BYTES, stream) != hipSuccess) { fprintf(stderr, "kernel_launch: memset failed\n"); return; }
    Args a{};
    for (int i = 0; i < 20; ++i) a.in[i] = (const float*)d_in[i];
    a.out = (float*)d_out; a.ws = (unsigned char*)d_ws;
    hipLaunchKernelGGL(fwd, dim3(grid), dim3(512), LDS_BYTES, stream, a);
    const hipError_t le = hipPeekAtLastError();
    if (le != hipSuccess) fprintf(stderr, "kernel_launch: launch failed: %s\n", hipGetErrorName(le));
}
```
